# Optimizing an MI355X kernel written in HIP

```python
import jax, jax.numpy as jnp
from jax import lax
import numpy as np

D_MODEL = 4096
BATCH = 4
SEQ = 4096
DEPTH = 1

POOL_GROUPS = 4
POOL_WINDOWS = (2, 4, 8, 16)
POOL_GROUP_DIM = D_MODEL // 8
POOL_WIDTH = POOL_GROUPS * POOL_GROUP_DIM
HEAD_DIM = 128
ATTN_HEADS = D_MODEL // (2 * HEAD_DIM)
ATTN_WIDTH = ATTN_HEADS * HEAD_DIM
MOBA_BLOCK = 256
MOBA_TOPK = 3
Q_CHUNK = 16
ROPE_THETA = 10000.0
IN_WIDTH = POOL_WIDTH + 3 * ATTN_WIDTH + 2 * D_MODEL
PEER_HEADS = 8
PEER_NKEYS = 128
PEER_EXPERTS = PEER_NKEYS * PEER_NKEYS
PEER_QDIM = 256
PEER_HALF = PEER_QDIM // 2
PEER_TOPK = 16
PEER_CHUNK = 32
EPS = 1e-6

kernel_name = "hybrid_pool_moba_peer_block"


def rmsnorm(x, g):
    xf = x.astype(jnp.float32)
    r = lax.rsqrt(jnp.mean(xf * xf, axis=-1, keepdims=True) + EPS)
    return (xf * r * g.astype(jnp.float32)).astype(x.dtype)


def rope(t, pos):
    half = HEAD_DIM // 2
    inv = ROPE_THETA ** (-jnp.arange(half, dtype=jnp.float32) / half)
    ang = pos.astype(jnp.float32)[:, None] * inv[None, :]
    cos, sin = jnp.cos(ang), jnp.sin(ang)
    t1 = t[..., :half].astype(jnp.float32)
    t2 = t[..., half:].astype(jnp.float32)
    out = jnp.concatenate([t1 * cos - t2 * sin, t2 * cos + t1 * sin], axis=-1)
    return out.astype(t.dtype)


def pool_mixer(xp, pool_w, pool_scale):
    B, S, _ = xp.shape
    xg = xp.reshape(B, S, POOL_GROUPS, POOL_GROUP_DIM).astype(jnp.float32)
    cs = jnp.concatenate([jnp.zeros((B, 1, POOL_GROUPS, POOL_GROUP_DIM), jnp.float32),
                          jnp.cumsum(xg, axis=1)], axis=1)
    t = jnp.arange(S)
    outs = []
    for g, w in enumerate(POOL_WINDOWS):
        lo = jnp.maximum(t + 1 - w, 0)
        cnt = jnp.minimum(t + 1, w).astype(jnp.float32)[None, :, None]
        mean = (cs[:, 1:, g] - cs[:, lo, g]) / cnt
        outs.append(mean - xg[:, :, g])
    y = jnp.stack(outs, axis=2).astype(xp.dtype)
    y = jnp.einsum('bsgc,gcd->bsgd', y, pool_w)
    return y.reshape(B, S, POOL_WIDTH) * pool_scale


def moba_attention(q, k, v):
    B, H, S, hd = q.shape
    L = MOBA_BLOCK
    nb = -(-S // L)
    pad = nb * L - S
    kp = jnp.pad(k, ((0, 0), (0, 0), (0, pad), (0, 0)))
    vp = jnp.pad(v, ((0, 0), (0, 0), (0, pad), (0, 0)))
    kb = kp.reshape(B, H, nb, L, hd)
    vb = vp.reshape(B, H, nb, L, hd)
    kmean = jnp.mean(kb.astype(jnp.float32), axis=3)
    topk = min(MOBA_TOPK, nb)
    scale = hd ** -0.5
    bi = jnp.arange(B)[:, None, None, None]
    hi = jnp.arange(H)[None, :, None, None]
    neg = jnp.float32(-1e30)

    def chunk(c):
        start = c * Q_CHUNK
        qc = lax.dynamic_slice_in_dim(q, start, Q_CHUNK, axis=2)
        qpos = start + jnp.arange(Q_CHUNK)
        own = start // L
        gate = jnp.einsum('bhqd,bhnd->bhqn', qc.astype(jnp.float32), kmean)
        gate = jnp.where(jnp.arange(nb) < own, gate, neg)
        _, gidx = lax.top_k(gate, topk)
        gvalid = gidx < own
        ksel = kb[bi, hi, gidx]
        vsel = vb[bi, hi, gidx]
        s_sel = jnp.einsum('bhqd,bhqnld->bhqnl', qc, ksel).astype(jnp.float32) * scale
        s_sel = jnp.where(gvalid[..., None], s_sel, neg)
        kown = lax.dynamic_index_in_dim(kb, own, axis=2, keepdims=False)
        vown = lax.dynamic_index_in_dim(vb, own, axis=2, keepdims=False)
        s_own = jnp.einsum('bhqd,bhld->bhql', qc, kown).astype(jnp.float32) * scale
        kpos = own * L + jnp.arange(L)
        s_own = jnp.where(kpos[None, :] <= qpos[:, None], s_own, neg)
        s = jnp.concatenate([s_sel.reshape(B, H, Q_CHUNK, topk * L), s_own], axis=-1)
        p = jax.nn.softmax(s, axis=-1).astype(v.dtype)
        p_sel = p[..., :topk * L].reshape(B, H, Q_CHUNK, topk, L)
        p_own = p[..., topk * L:]
        return (jnp.einsum('bhqnl,bhqnld->bhqd', p_sel, vsel)
                + jnp.einsum('bhql,bhld->bhqd', p_own, vown))

    outs = lax.map(chunk, jnp.arange(S // Q_CHUNK))
    return jnp.transpose(outs, (1, 2, 0, 3, 4)).reshape(B, H, S, hd)


def peer_ffn(xn, wq, subkeys, u, v):
    B, S, D = xn.shape
    q = (xn @ wq).reshape(B, S, PEER_HEADS, 2, PEER_HALF).astype(jnp.float32)
    s = jnp.einsum('bshpd,hpnd->bshpn', q, subkeys.astype(jnp.float32))
    sv, si = lax.top_k(s, PEER_TOPK)
    cand = sv[..., 0, :, None] + sv[..., 1, None, :]
    cv, ci = lax.top_k(cand.reshape(B, S, PEER_HEADS, PEER_TOPK * PEER_TOPK), PEER_TOPK)
    i1 = jnp.take_along_axis(si[..., 0, :], ci // PEER_TOPK, axis=-1)
    i2 = jnp.take_along_axis(si[..., 1, :], ci % PEER_TOPK, axis=-1)
    idx = i1 * PEER_NKEYS + i2
    g = jax.nn.softmax(cv, axis=-1).astype(xn.dtype)
    T = B * S
    HK = PEER_HEADS * PEER_TOPK
    n = T // PEER_CHUNK

    def body(args):
        xc, ic, gc = args
        a = jnp.einsum('cd,ced->ce', xc, u[ic])
        act = jax.nn.gelu(a, approximate=False) * gc
        return jnp.einsum('ce,ced->cd', act, v[ic])

    out = lax.map(body, (xn.reshape(n, PEER_CHUNK, D),
                         idx.reshape(n, PEER_CHUNK, HK),
                         g.reshape(n, PEER_CHUNK, HK)))
    return out.reshape(B, S, D)


def setup_inputs(seed: int = 0) -> dict:
    key = jax.random.key(seed)
    ks = jax.random.split(key, 16)
    f32 = jnp.float32
    nrm = lambda k, shape, s: jax.random.normal(k, shape, f32) * s
    return {
        "x": jax.random.normal(ks[0], (BATCH, SEQ, D_MODEL), f32),
        "norm_mix": 1.0 + nrm(ks[1], (DEPTH, D_MODEL), 0.02),
        "w_in": nrm(ks[2], (DEPTH, D_MODEL, IN_WIDTH), D_MODEL ** -0.5),
        "pool_w": nrm(ks[3], (DEPTH, POOL_GROUPS, POOL_GROUP_DIM, POOL_GROUP_DIM), POOL_GROUP_DIM ** -0.5),
        "pool_scale": 1.0 + nrm(ks[4], (DEPTH, POOL_WIDTH), 0.1),
        "q_norm": 1.0 + nrm(ks[5], (DEPTH, HEAD_DIM), 0.02),
        "k_norm": 1.0 + nrm(ks[6], (DEPTH, HEAD_DIM), 0.02),
        "w_pool_out": nrm(ks[7], (DEPTH, POOL_WIDTH, D_MODEL), POOL_WIDTH ** -0.5),
        "w_attn_out": nrm(ks[8], (DEPTH, ATTN_WIDTH, D_MODEL), ATTN_WIDTH ** -0.5),
        "w_o": nrm(ks[9], (DEPTH, D_MODEL, D_MODEL), D_MODEL ** -0.5),
        "norm_ffn": 1.0 + nrm(ks[10], (DEPTH, D_MODEL), 0.02),
        "peer_wq": nrm(ks[11], (DEPTH, D_MODEL, PEER_HEADS * PEER_QDIM), D_MODEL ** -0.5),
        "peer_subkeys": nrm(ks[12], (DEPTH, PEER_HEADS, 2, PEER_NKEYS, PEER_HALF), PEER_HALF ** -0.5),
        "peer_u": nrm(ks[13], (DEPTH, PEER_EXPERTS, D_MODEL), D_MODEL ** -0.5),
        "peer_v": nrm(ks[14], (DEPTH, PEER_EXPERTS, D_MODEL), 0.5),
    }


def reference(x, norm_mix, w_in, pool_w, pool_scale, q_norm, k_norm, w_pool_out,
              w_attn_out, w_o, norm_ffn, peer_wq, peer_subkeys, peer_u, peer_v):
    B, S, D = x.shape
    pos = jnp.arange(S)
    h = x
    for l in range(DEPTH):
        xn = rmsnorm(h, norm_mix[l])
        z = xn @ w_in[l]
        o = 0
        zp = z[..., o:o + POOL_WIDTH]; o += POOL_WIDTH
        zq = z[..., o:o + ATTN_WIDTH]; o += ATTN_WIDTH
        zk = z[..., o:o + ATTN_WIDTH]; o += ATTN_WIDTH
        zv = z[..., o:o + ATTN_WIDTH]; o += ATTN_WIDTH
        g_pool = z[..., o:o + D]; o += D
        g_attn = z[..., o:o + D]

        y_pool = pool_mixer(zp, pool_w[l], pool_scale[l])

        heads = lambda t: jnp.transpose(t.reshape(B, S, ATTN_HEADS, HEAD_DIM), (0, 2, 1, 3))
        q = rope(rmsnorm(heads(zq), q_norm[l]), pos)
        k = rope(rmsnorm(heads(zk), k_norm[l]), pos)
        v = heads(zv)
        att = moba_attention(q, k, v)
        y_attn = jnp.transpose(att, (0, 2, 1, 3)).reshape(B, S, ATTN_WIDTH)

        merged = (jax.nn.sigmoid(g_pool) * (y_pool @ w_pool_out[l])
                  + jax.nn.sigmoid(g_attn) * (y_attn @ w_attn_out[l]))
        h = h + merged @ w_o[l]

        hn = rmsnorm(h, norm_ffn[l])
        h = h + peer_ffn(hn, peer_wq[l], peer_subkeys[l], peer_u[l], peer_v[l])
    return h
```

```cpp
#include <hip/hip_runtime.h>
#include <cstdio>
#include <cstdint>


#define PH_REP 0x0u
#ifndef PG8_ALIGN
#define PG8_ALIGN true
#endif
#ifndef PH_REP
#define PH_REP 0u
#endif
#ifndef MK_N_LAUNCHES
#define MK_N_LAUNCHES 1
#endif

constexpr int BATCH = 4, SEQ = 4096, DM = 4096, T = BATCH * SEQ;
constexpr int PW = 2048, AW = 2048, HD = 128, NH = 16, INW = 16384;
constexpr int MOBA_L = 256, NBLK = SEQ / MOBA_L;
constexpr int PEER_H = 8, PEER_NK = 128, PEER_E = 16384, PEER_K = 16, PEER_HK = PEER_H * PEER_K;
constexpr float EPS = 1e-6f;
constexpr int N_PHASES = 16;

constexpr size_t MiB = 1u << 20;
constexpr size_t WS_CTL = 0, CTL_ZERO_BYTES = 1 * MiB;
constexpr size_t CTL_CMAX_WIN = 128 * 1024;
constexpr size_t CTL_CMAX_V = 192 * 1024;
constexpr size_t CTL_CMAX_WO = 208 * 1024, CTL_CMAX_WPO = 224 * 1024, CTL_CMAX_WAO = 240 * 1024;
constexpr size_t WS_ROPE = 1 * MiB;
constexpr size_t WS_KMEAN = 3 * MiB;
constexpr size_t WS_SEL = 4 * MiB;
constexpr size_t WS_PIDX = 5 * MiB;
constexpr size_t WS_PG = 13 * MiB;
constexpr size_t WS_SCALE = 21 * MiB;
constexpr size_t WS_POOLW = 22 * MiB;
constexpr size_t WS_WPO = 24 * MiB;
constexpr size_t WS_WAO = 40 * MiB;
constexpr size_t WS_WO = 56 * MiB;
constexpr size_t WS_WQ = 88 * MiB;
constexpr size_t WS_U8 = 104 * MiB;
constexpr size_t WS_VT8 = 168 * MiB;
constexpr size_t WS_WIN8 = 232 * MiB;
constexpr size_t WS_XN8 = 296 * MiB;
constexpr size_t WS_YPRE = 360 * MiB;
constexpr size_t WS_MRG = 424 * MiB;
constexpr size_t WS_ACT8 = 232 * MiB;
constexpr size_t WS_Z = 552 * MiB;
constexpr size_t WS_H16 = 808 * MiB;
constexpr size_t WS_YP8 = 1064 * MiB;
constexpr size_t WS_YA8 = 1096 * MiB;
constexpr size_t WS_END = 1128 * MiB;
constexpr size_t ZSLOT = (size_t)T * 2048;

constexpr int CW_TMO = 0;
constexpr int CW_BAR = 4096;

constexpr int RING_BYTES = 131072;
constexpr int LDSCTL_OFF = 151552, MISC_OFF = LDSCTL_OFF + 320;
constexpr int LDS_BYTES = 155648;
constexpr int NWAVES = 8;

#define GAS __attribute__((address_space(1)))
#define LAS __attribute__((address_space(3)))
typedef unsigned short bf16;
typedef unsigned v4u __attribute__((ext_vector_type(4)));
typedef unsigned v2u __attribute__((ext_vector_type(2)));
typedef float f32x4 __attribute__((ext_vector_type(4)));
typedef float f32x2 __attribute__((ext_vector_type(2)));
typedef GAS unsigned gu32;
#define RLX_AGENT __ATOMIC_RELAXED, __HIP_MEMORY_SCOPE_AGENT
#define LDS_WAIT() asm volatile("s_waitcnt lgkmcnt(0)" ::: "memory")
#define VM_WAIT() asm volatile("s_waitcnt vmcnt(0)" ::: "memory")

__device__ __forceinline__ unsigned f2bf(float f) { unsigned u = __builtin_bit_cast(unsigned, f); return (u + 0x7fffu + ((u >> 16) & 1u)) >> 16; }
__device__ __forceinline__ unsigned pk2(float lo, float hi) { return f2bf(lo) | (f2bf(hi) << 16); }
__device__ __forceinline__ float bflo(unsigned w) { return __builtin_bit_cast(float, w << 16); }
__device__ __forceinline__ float bfhi(unsigned w) { return __builtin_bit_cast(float, w & 0xffff0000u); }
__device__ __forceinline__ float wave_sum(float v) {
#pragma unroll
    for (int o = 1; o < 64; o <<= 1) v += __shfl_xor(v, o);
    return v;
}

namespace pg8 {
#define PG8_LAS __attribute__((address_space(3)))
typedef unsigned short bf16_t;
typedef short bf16x8 __attribute__((ext_vector_type(8)));
typedef float f32x4 __attribute__((ext_vector_type(4)));
typedef unsigned u32x4 __attribute__((ext_vector_type(4)));
constexpr int BM = 256, BK = 64, HALF = 128, HTB = HALF * BK * 2, STAGE_BYTES = 8 * HTB, NXCD = 8, WGM = 8;

__host__ __device__ __forceinline__ int lds_byte(int r, int c) { const int st = (r >> 4) * 2 + (c >> 5), rr = r & 15, cc = c & 31, ob = rr * 64 + cc * 2; return st * 1024 + (ob ^ (((ob >> 9) & 1) << 5)); }
__host__ __device__ __forceinline__ void stage_rc(int b, int& R, int& C) { const int st = b / 1024, sb = b % 1024, swz = sb ^ (((sb >> 9) & 1) << 5); R = (st >> 1) * 16 + swz / 64; C = (st & 1) * 32 + (swz % 64) / 2; }
__host__ __device__ __forceinline__ int perm32(int rho) { const int n = rho >> 4, i = rho & 15; return 8 * (i >> 2) + 4 * n + (i & 3); }

struct Unit { int pm, pn, ak; };
struct Gemm { const void* A; const void* Bt; int Kb, lda, ldb; };
typedef int i32x4 __attribute__((ext_vector_type(4)));

struct StaticOrder {
    int nM, nN, nwg, G, c;
    __host__ __device__ __forceinline__ void init(int M, int N, int G_, int c_) { nM = M / BM; nN = N / BM; nwg = nM * nN; G = G_; c = c_; }
    __host__ __device__ __forceinline__ bool next(int i, Unit& u) const {
        const long L = (long)i * G + c; if (L >= nwg) return false;
        int wgid = (int)L; { const int q = nwg / NXCD, r = nwg % NXCD, xcd = wgid % NXCD, off = wgid / NXCD; wgid = (xcd < r ? xcd * (q + 1) : r * (q + 1) + (xcd - r) * q) + off; }
        const int nig = WGM * nN, gid = wgid / nig, fm = gid * WGM, gsz = (nM - fm) < WGM ? (nM - fm) : WGM;
        u.pm = fm + ((wgid % nig) % gsz); u.pn = (wgid % nig) / gsz; u.ak = 0; return true;
    }
};
struct PoolOrder : StaticOrder {
    __host__ __device__ bool next(int i, Unit& u) const { if (!StaticOrder::next(i, u)) return false; u.ak = (u.pn >> 1) * 512 * 2; return true; }
};

__device__ __forceinline__ unsigned cvt_pk_bf16(float lo, float hi) { unsigned r; asm volatile("v_cvt_pk_bf16_f32 %0, %1, %2" : "=v"(r) : "v"(lo), "v"(hi)); return r; }
typedef float f32x2 __attribute__((ext_vector_type(2)));
__device__ __forceinline__ f32x2 gelu_pk(f32x2 v) {
    const f32x2 av = __builtin_elementwise_abs(v), d = av * 0.2316418882f + 1.0f;
    f32x2 t; t.x = __builtin_amdgcn_rcpf(d.x); t.y = __builtin_amdgcn_rcpf(d.y);
    f32x2 q = t * 0.5307027145f + (-0.7265760135f); q = q * t + 0.7107068705f; q = q * t + (-0.142248368f); q = q * t + 0.127414796f; q = q * t;
    const f32x2 s = (v * v) * (-0.72134752044f);
    f32x2 e; e.x = __builtin_amdgcn_exp2f(s.x); e.y = __builtin_amdgcn_exp2f(s.y);
    const f32x2 m = v * (q * e), r = v - m;
    f32x2 o; o.x = v.x < 0.f ? m.x : r.x; o.y = v.y < 0.f ? m.y : r.y; return o;
}
__device__ __forceinline__ float sigmoidf_fast(float v) { return __builtin_amdgcn_rcpf(1.0f + __builtin_amdgcn_exp2f(v * -1.4426950408889634f)); }

struct EpiZ {
    static constexpr bool I8 = false; typedef f32x4 acc_t; static constexpr bool PERM = true;
    bf16_t* Z;
    __device__ __forceinline__ void operator()(const f32x4 (&acc)[2][2][4][2], const Unit& u, int wr, int wc, int fr, int fq) const {
        const int row0 = u.pm * BM + wr * 64 + fr, ct = u.pn * BM, t = ct >> 11;
        bf16_t* base = Z + (size_t)t * ZSLOT; const int col0 = (ct & 2047) + wc * 32 + 8 * fq; const bool sig = t >= 4;
#pragma unroll
        for (int ai = 0; ai < 2; ++ai)
#pragma unroll
            for (int m = 0; m < 4; ++m) { bf16_t* rowp = base + (size_t)(row0 + ai * HALF + m * 16) * 2048 + col0;
#pragma unroll
                for (int bj = 0; bj < 2; ++bj) { f32x4 v0 = acc[ai][bj][m][0], v1 = acc[ai][bj][m][1];
                    if (sig) {
#pragma unroll
                        for (int j = 0; j < 4; ++j) { v0[j] = sigmoidf_fast(v0[j]); v1[j] = sigmoidf_fast(v1[j]); } }
                    u32x4 w; w.x = cvt_pk_bf16(v0[0], v0[1]); w.y = cvt_pk_bf16(v0[2], v0[3]); w.z = cvt_pk_bf16(v1[0], v1[1]); w.w = cvt_pk_bf16(v1[2], v1[3]);
                    *(u32x4*)(rowp + bj * HALF) = w; } }
    }
};
struct EpiBf16 {
    static constexpr bool I8 = false; typedef f32x4 acc_t; static constexpr bool PERM = true;
    bf16_t* O; int ldc;
    __device__ __forceinline__ void operator()(const f32x4 (&acc)[2][2][4][2], const Unit& u, int wr, int wc, int fr, int fq) const {
        const int row0 = u.pm * BM + wr * 64 + fr, col0 = u.pn * BM + wc * 32 + 8 * fq;
#pragma unroll
        for (int ai = 0; ai < 2; ++ai)
#pragma unroll
            for (int m = 0; m < 4; ++m) { bf16_t* rowp = O + (size_t)(row0 + ai * HALF + m * 16) * ldc + col0;
#pragma unroll
                for (int bj = 0; bj < 2; ++bj) { const f32x4 v0 = acc[ai][bj][m][0], v1 = acc[ai][bj][m][1];
                    u32x4 w; w.x = cvt_pk_bf16(v0[0], v0[1]); w.y = cvt_pk_bf16(v0[2], v0[3]); w.z = cvt_pk_bf16(v1[0], v1[1]); w.w = cvt_pk_bf16(v1[2], v1[3]);
                    *(u32x4*)(rowp + bj * HALF) = w; } }
    }
};
struct EpiBf16Row {
    static constexpr bool I8 = false; typedef f32x4 acc_t; static constexpr bool PERM = true;
    bf16_t* O; int ldc; const float* rs;
    __device__ __forceinline__ void operator()(const f32x4 (&acc)[2][2][4][2], const Unit& u, int wr, int wc, int fr, int fq) const {
        const int row0 = u.pm * BM + wr * 64 + fr, col0 = u.pn * BM + wc * 32 + 8 * fq;
        float srw[2][4];
#pragma unroll
        for (int ai = 0; ai < 2; ++ai)
#pragma unroll
            for (int m = 0; m < 4; ++m) srw[ai][m] = rs[row0 + ai * HALF + m * 16];
#pragma unroll
        for (int ai = 0; ai < 2; ++ai)
#pragma unroll
            for (int m = 0; m < 4; ++m) { bf16_t* rowp = O + (size_t)(row0 + ai * HALF + m * 16) * ldc + col0; const float sr = srw[ai][m];
#pragma unroll
                for (int bj = 0; bj < 2; ++bj) { const f32x4 v0 = acc[ai][bj][m][0] * sr, v1 = acc[ai][bj][m][1] * sr;
                    u32x4 w; w.x = cvt_pk_bf16(v0[0], v0[1]); w.y = cvt_pk_bf16(v0[2], v0[3]); w.z = cvt_pk_bf16(v1[0], v1[1]); w.w = cvt_pk_bf16(v1[2], v1[3]);
                    *(u32x4*)(rowp + bj * HALF) = w; } }
    }
};
struct EpiScale {
    static constexpr bool I8 = false; typedef f32x4 acc_t; static constexpr bool PERM = true;
    bf16_t* O; int ldc; const float* scale;
    __device__ __forceinline__ void operator()(const f32x4 (&acc)[2][2][4][2], const Unit& u, int wr, int wc, int fr, int fq) const {
        const int row0 = u.pm * BM + wr * 64 + fr, col0 = u.pn * BM + wc * 32 + 8 * fq;
        f32x4 sv[2][2];
#pragma unroll
        for (int bj = 0; bj < 2; ++bj)
#pragma unroll
            for (int n = 0; n < 2; ++n) sv[bj][n] = *(const f32x4*)(scale + col0 + bj * HALF + 4 * n);
#pragma unroll
        for (int ai = 0; ai < 2; ++ai)
#pragma unroll
            for (int m = 0; m < 4; ++m) { bf16_t* rowp = O + (size_t)(row0 + ai * HALF + m * 16) * ldc + col0;
#pragma unroll
                for (int bj = 0; bj < 2; ++bj) { const f32x4 v0 = acc[ai][bj][m][0] * sv[bj][0], v1 = acc[ai][bj][m][1] * sv[bj][1];
                    u32x4 w; w.x = cvt_pk_bf16(v0[0], v0[1]); w.y = cvt_pk_bf16(v0[2], v0[3]); w.z = cvt_pk_bf16(v1[0], v1[1]); w.w = cvt_pk_bf16(v1[2], v1[3]);
                    *(u32x4*)(rowp + bj * HALF) = w; } }
    }
};
template <bool ADD> struct EpiGate {
    static constexpr bool I8 = false; typedef f32x4 acc_t; static constexpr bool PERM = true;
    bf16_t* O; const bf16_t* G;
    __device__ __forceinline__ void operator()(const f32x4 (&acc)[2][2][4][2], const Unit& u, int wr, int wc, int fr, int fq) const {
        const int row0 = u.pm * BM + wr * 64 + fr, ct = u.pn * BM, t = ct >> 11;
        const bf16_t* gbase = G + (size_t)t * ZSLOT; const int gcol0 = (ct & 2047) + wc * 32 + 8 * fq, col0 = ct + wc * 32 + 8 * fq;
        u32x4 gw[2][2], ow[2][2];
#define EG_LOAD(slot, g_) do { const size_t r_ = (size_t)(row0 + ((g_) >> 2) * HALF + ((g_) & 3) * 16); \
            gw[slot][0] = *(const u32x4*)(gbase + r_ * 2048 + gcol0); gw[slot][1] = *(const u32x4*)(gbase + r_ * 2048 + gcol0 + HALF); \
            if (ADD) { ow[slot][0] = *(const u32x4*)(O + r_ * 4096 + col0); ow[slot][1] = *(const u32x4*)(O + r_ * 4096 + col0 + HALF); } } while (0)
        EG_LOAD(0, 0);
#pragma unroll
        for (int g = 0; g < 8; ++g) { const int ai = g >> 2, m = g & 3, cur = g & 1;
            if (g + 1 < 8) EG_LOAD(cur ^ 1, g + 1);
            bf16_t* rowp = O + (size_t)(row0 + ai * HALF + m * 16) * 4096 + col0;
#pragma unroll
            for (int bj = 0; bj < 2; ++bj) { const u32x4 gq = gw[cur][bj];
                f32x4 v0 = acc[ai][bj][m][0], v1 = acc[ai][bj][m][1];
                v0[0] *= bflo(gq.x); v0[1] *= bfhi(gq.x); v0[2] *= bflo(gq.y); v0[3] *= bfhi(gq.y); v1[0] *= bflo(gq.z); v1[1] *= bfhi(gq.z); v1[2] *= bflo(gq.w); v1[3] *= bfhi(gq.w);
                if (ADD) { const u32x4 oq = ow[cur][bj];
                    v0[0] += bflo(oq.x); v0[1] += bfhi(oq.x); v0[2] += bflo(oq.y); v0[3] += bfhi(oq.y); v1[0] += bflo(oq.z); v1[1] += bfhi(oq.z); v1[2] += bflo(oq.w); v1[3] += bfhi(oq.w); }
                u32x4 w; w.x = cvt_pk_bf16(v0[0], v0[1]); w.y = cvt_pk_bf16(v0[2], v0[3]); w.z = cvt_pk_bf16(v1[0], v1[1]); w.w = cvt_pk_bf16(v1[2], v1[3]);
                *(u32x4*)(rowp + bj * HALF) = w; } }
#undef EG_LOAD
    }
};
struct EpiF32 {
    static constexpr bool I8 = false; typedef f32x4 acc_t; static constexpr bool PERM = false;
    float* C; int ldc; const float* base;
    __device__ __forceinline__ void operator()(const f32x4 (&acc)[2][2][4][2], const Unit& u, int wr, int wc, int fr, int fq) const {
        const int row0 = u.pm * BM + wr * 64 + fr, col0 = u.pn * BM + wc * 32 + 4 * fq;
        f32x4 bv[2][2][2];
#define EF_LOAD(slot, g_) do { const size_t off_ = (size_t)(row0 + ((g_) >> 2) * HALF + ((g_) & 3) * 16) * ldc + col0; \
            _Pragma("unroll") for (int bj = 0; bj < 2; ++bj) _Pragma("unroll") for (int n = 0; n < 2; ++n) bv[slot][bj][n] = *(const f32x4*)(base + off_ + bj * HALF + n * 16); } while (0)
        if (base) EF_LOAD(0, 0);
#pragma unroll
        for (int g = 0; g < 8; ++g) { const int ai = g >> 2, m = g & 3, cur = g & 1;
            if (base && g + 1 < 8) EF_LOAD(cur ^ 1, g + 1);
            const size_t off = (size_t)(row0 + ai * HALF + m * 16) * ldc + col0;
#pragma unroll
            for (int bj = 0; bj < 2; ++bj)
#pragma unroll
                for (int n = 0; n < 2; ++n) { f32x4 o = acc[ai][bj][m][n]; if (base) o += bv[cur][bj][n]; *(f32x4*)(C + off + bj * HALF + n * 16) = o; } }
#undef EF_LOAD
    }
};
struct EpiGelu {
    static constexpr bool I8 = false; typedef f32x4 acc_t; static constexpr bool PERM = true;
    bf16_t* O; int ldc;
    __device__ __forceinline__ void operator()(const f32x4 (&acc)[2][2][4][2], const Unit& u, int wr, int wc, int fr, int fq) const {
        const int row0 = u.pm * BM + wr * 64 + fr, col0 = u.pn * BM + wc * 32 + 8 * fq;
#pragma unroll
        for (int ai = 0; ai < 2; ++ai)
#pragma unroll
            for (int m = 0; m < 4; ++m) { bf16_t* rowp = O + (size_t)(row0 + ai * HALF + m * 16) * ldc + col0;
#pragma unroll
                for (int bj = 0; bj < 2; ++bj) { const f32x4 v0 = acc[ai][bj][m][0], v1 = acc[ai][bj][m][1];
                    const f32x2 a = gelu_pk((f32x2){v0[0], v0[1]}), b = gelu_pk((f32x2){v0[2], v0[3]}), c = gelu_pk((f32x2){v1[0], v1[1]}), d = gelu_pk((f32x2){v1[2], v1[3]});
                    u32x4 w; w.x = cvt_pk_bf16(a.x, a.y); w.y = cvt_pk_bf16(b.x, b.y); w.z = cvt_pk_bf16(c.x, c.y); w.w = cvt_pk_bf16(d.x, d.y);
                    *(u32x4*)(rowp + bj * HALF) = w; } }
    }
};

struct EpiZ8 {
    static constexpr bool I8 = true; typedef i32x4 acc_t; static constexpr bool PERM = true;
    bf16_t* Z; const float* sa; const float* sb;
    __device__ __forceinline__ void operator()(const i32x4 (&acc)[2][2][4][2], const Unit& u, int wr, int wc, int fr, int fq) const {
        const int row0 = u.pm * BM + wr * 64 + fr, ct = u.pn * BM, t = ct >> 11;
        bf16_t* base = Z + (size_t)t * ZSLOT; const int col0 = (ct & 2047) + wc * 32 + 8 * fq; const bool sig = t >= 4;
        f32x4 sv[2][2];
#pragma unroll
        for (int bj = 0; bj < 2; ++bj)
#pragma unroll
            for (int n = 0; n < 2; ++n) sv[bj][n] = *(const f32x4*)(sb + ct + wc * 32 + 8 * fq + bj * HALF + 4 * n);
        float srw[2][4];
#pragma unroll
        for (int ai = 0; ai < 2; ++ai)
#pragma unroll
            for (int m = 0; m < 4; ++m) srw[ai][m] = sa[row0 + ai * HALF + m * 16];
#pragma unroll
        for (int ai = 0; ai < 2; ++ai)
#pragma unroll
            for (int m = 0; m < 4; ++m) { const int r = row0 + ai * HALF + m * 16; const float sr = srw[ai][m]; bf16_t* rowp = base + (size_t)r * 2048 + col0;
#pragma unroll
                for (int bj = 0; bj < 2; ++bj) { f32x4 v0 = __builtin_convertvector(acc[ai][bj][m][0], f32x4) * sv[bj][0] * sr, v1 = __builtin_convertvector(acc[ai][bj][m][1], f32x4) * sv[bj][1] * sr;
                    if (sig) {
                        unsigned q[8];
#pragma unroll
                        for (int j = 0; j < 4; ++j) { q[j] = (unsigned)__builtin_rintf(sigmoidf_fast(v0[j]) * 255.f); q[4 + j] = (unsigned)__builtin_rintf(sigmoidf_fast(v1[j]) * 255.f); }
                        typedef unsigned u32x2 __attribute__((ext_vector_type(2)));
                        *(u32x2*)((unsigned char*)base + (size_t)r * 2048 + col0 + bj * HALF) = (u32x2){q[0] | (q[1] << 8) | (q[2] << 16) | (q[3] << 24), q[4] | (q[5] << 8) | (q[6] << 16) | (q[7] << 24)};
                    } else {
                        u32x4 w; w.x = cvt_pk_bf16(v0[0], v0[1]); w.y = cvt_pk_bf16(v0[2], v0[3]); w.z = cvt_pk_bf16(v1[0], v1[1]); w.w = cvt_pk_bf16(v1[2], v1[3]);
                        *(u32x4*)(rowp + bj * HALF) = w; } } }
    }
};
template <bool GELU> struct EpiAct8 {
    static constexpr bool I8 = true; typedef i32x4 acc_t; static constexpr bool PERM = true; static constexpr bool WIDE = true;
    bf16_t* O; int ldc; const float* sa; const float* sb;
    __device__ __forceinline__ void operator()(const i32x4 (&acc)[2][2][4][2], const Unit& u, int wr, int wc, int fr, int fq) const {
        const int row0 = u.pm * BM + wr * 64 + fr, col0 = u.pn * BM + wc * 64 + 16 * fq;
        f32x4 sv[2][2];
#pragma unroll
        for (int bj = 0; bj < 2; ++bj)
#pragma unroll
            for (int n = 0; n < 2; ++n) { sv[bj][n] = *(const f32x4*)(sb + col0 + bj * 8 + 4 * n); if constexpr (!GELU) sv[bj][n] = sv[bj][n] * (1.f / 16.f); }
        float srw[2][4];
#pragma unroll
        for (int ai = 0; ai < 2; ++ai)
#pragma unroll
            for (int m = 0; m < 4; ++m) srw[ai][m] = GELU ? sa[row0 + ai * HALF + m * 16] : 1.f;
#pragma unroll
        for (int ai = 0; ai < 2; ++ai)
#pragma unroll
            for (int m = 0; m < 4; ++m) { const int r = row0 + ai * HALF + m * 16; const float sr = srw[ai][m]; bf16_t* rowp = O + (size_t)r * ldc + col0;
                int pk[4] = {0, 0, 0, 0};
#pragma unroll
                for (int bj = 0; bj < 2; ++bj) { f32x4 v0 = __builtin_convertvector(acc[ai][bj][m][0], f32x4) * sv[bj][0], v1 = __builtin_convertvector(acc[ai][bj][m][1], f32x4) * sv[bj][1];
                    if constexpr (GELU) { v0 = v0 * sr; v1 = v1 * sr; }
                    if constexpr (GELU) { const f32x2 a = gelu_pk((f32x2){v0[0], v0[1]}), b = gelu_pk((f32x2){v0[2], v0[3]}), c = gelu_pk((f32x2){v1[0], v1[1]}), d = gelu_pk((f32x2){v1[2], v1[3]});
                        u32x4 w; w.x = cvt_pk_bf16(a.x, a.y); w.y = cvt_pk_bf16(b.x, b.y); w.z = cvt_pk_bf16(c.x, c.y); w.w = cvt_pk_bf16(d.x, d.y); *(u32x4*)(rowp + bj * 8) = w; }
                    else { int lo = 0, hi = 0;
                        lo = __builtin_amdgcn_cvt_pk_fp8_f32(v0[0], v0[1], lo, false); lo = __builtin_amdgcn_cvt_pk_fp8_f32(v0[2], v0[3], lo, true);
                        hi = __builtin_amdgcn_cvt_pk_fp8_f32(v1[0], v1[1], hi, false); hi = __builtin_amdgcn_cvt_pk_fp8_f32(v1[2], v1[3], hi, true);
                        pk[2 * bj] = lo; pk[2 * bj + 1] = hi; } }
                if constexpr (!GELU) *(i32x4*)((unsigned char*)O + (size_t)r * ldc + col0) = (i32x4){pk[0], pk[1], pk[2], pk[3]}; }
    }
};
struct EpiBf16_8 {
    static constexpr bool I8 = true; typedef i32x4 acc_t; static constexpr bool PERM = true;
    bf16_t* O; int ldc; const float* sa; const float* sb;
    __device__ __forceinline__ void operator()(const i32x4 (&acc)[2][2][4][2], const Unit& u, int wr, int wc, int fr, int fq) const {
        const int row0 = u.pm * BM + wr * 64 + fr, col0 = u.pn * BM + wc * 32 + 8 * fq;
        f32x4 sv[2][2];
#pragma unroll
        for (int bj = 0; bj < 2; ++bj)
#pragma unroll
            for (int n = 0; n < 2; ++n) sv[bj][n] = *(const f32x4*)(sb + col0 + bj * HALF + 4 * n);
        float srw[2][4];
#pragma unroll
        for (int ai = 0; ai < 2; ++ai)
#pragma unroll
            for (int m = 0; m < 4; ++m) srw[ai][m] = sa[row0 + ai * HALF + m * 16];
#pragma unroll
        for (int ai = 0; ai < 2; ++ai)
#pragma unroll
            for (int m = 0; m < 4; ++m) { const float sr = srw[ai][m]; bf16_t* rowp = O + (size_t)(row0 + ai * HALF + m * 16) * ldc + col0;
#pragma unroll
                for (int bj = 0; bj < 2; ++bj) { const f32x4 v0 = __builtin_convertvector(acc[ai][bj][m][0], f32x4) * sv[bj][0] * sr, v1 = __builtin_convertvector(acc[ai][bj][m][1], f32x4) * sv[bj][1] * sr;
                    u32x4 w; w.x = cvt_pk_bf16(v0[0], v0[1]); w.y = cvt_pk_bf16(v0[2], v0[3]); w.z = cvt_pk_bf16(v1[0], v1[1]); w.w = cvt_pk_bf16(v1[2], v1[3]);
                    *(u32x4*)(rowp + bj * HALF) = w; } }
    }
};
template <bool ADD> struct EpiGate8 {
    static constexpr bool I8 = true; typedef i32x4 acc_t; static constexpr bool PERM = true;
    bf16_t* O; const bf16_t* G; const float* sa; const float* sb;
    __device__ __forceinline__ void operator()(const i32x4 (&acc)[2][2][4][2], const Unit& u, int wr, int wc, int fr, int fq) const {
        const int row0 = u.pm * BM + wr * 64 + fr, ct = u.pn * BM, t = ct >> 11;
        const bf16_t* gbase = G + (size_t)t * ZSLOT; const int gcol0 = (ct & 2047) + wc * 32 + 8 * fq, col0 = ct + wc * 32 + 8 * fq;
        f32x4 sv[2][2]; float srw[8];
#pragma unroll
        for (int bj = 0; bj < 2; ++bj)
#pragma unroll
            for (int n = 0; n < 2; ++n) sv[bj][n] = *(const f32x4*)(sb + col0 + bj * HALF + 4 * n);
#pragma unroll
        for (int g = 0; g < 8; ++g) srw[g] = sa[row0 + (g >> 2) * HALF + (g & 3) * 16];
        typedef unsigned u32x2 __attribute__((ext_vector_type(2)));
        const unsigned char* gbase8 = (const unsigned char*)gbase;
        u32x2 gw[2][2]; u32x4 ow[2][2];
#define EG_LOAD(slot, g_) do { const size_t r_ = (size_t)(row0 + ((g_) >> 2) * HALF + ((g_) & 3) * 16); \
            gw[slot][0] = *(const u32x2*)(gbase8 + r_ * 2048 + gcol0); gw[slot][1] = *(const u32x2*)(gbase8 + r_ * 2048 + gcol0 + HALF); \
            if (ADD) { ow[slot][0] = *(const u32x4*)(O + r_ * 4096 + col0); ow[slot][1] = *(const u32x4*)(O + r_ * 4096 + col0 + HALF); } } while (0)
        EG_LOAD(0, 0);
#pragma unroll
        for (int g = 0; g < 8; ++g) { const int ai = g >> 2, m = g & 3, cur = g & 1;
            if (g + 1 < 8) EG_LOAD(cur ^ 1, g + 1);
            bf16_t* rowp = O + (size_t)(row0 + ai * HALF + m * 16) * 4096 + col0; const float sr = srw[g];
#pragma unroll
            for (int bj = 0; bj < 2; ++bj) { const u32x2 gq = gw[cur][bj]; const float s255 = sr * (1.f / 255.f);
                f32x4 v0 = __builtin_convertvector(acc[ai][bj][m][0], f32x4) * sv[bj][0] * s255, v1 = __builtin_convertvector(acc[ai][bj][m][1], f32x4) * sv[bj][1] * s255;
                v0[0] *= (float)(gq.x & 255u); v0[1] *= (float)((gq.x >> 8) & 255u); v0[2] *= (float)((gq.x >> 16) & 255u); v0[3] *= (float)(gq.x >> 24);
                v1[0] *= (float)(gq.y & 255u); v1[1] *= (float)((gq.y >> 8) & 255u); v1[2] *= (float)((gq.y >> 16) & 255u); v1[3] *= (float)(gq.y >> 24);
                if (ADD) { const u32x4 oq = ow[cur][bj];
                    v0[0] += bflo(oq.x); v0[1] += bfhi(oq.x); v0[2] += bflo(oq.y); v0[3] += bfhi(oq.y); v1[0] += bflo(oq.z); v1[1] += bfhi(oq.z); v1[2] += bflo(oq.w); v1[3] += bfhi(oq.w); }
                u32x4 w; w.x = cvt_pk_bf16(v0[0], v0[1]); w.y = cvt_pk_bf16(v0[2], v0[3]); w.z = cvt_pk_bf16(v1[0], v1[1]); w.w = cvt_pk_bf16(v1[2], v1[3]);
                *(u32x4*)(rowp + bj * HALF) = w; } }
#undef EG_LOAD
    }
};
struct EpiH16_8 {
    static constexpr bool I8 = true; typedef i32x4 acc_t; static constexpr bool PERM = true;
    bf16_t* O; int ldc; const float* base; const float* sa; const float* sb;
    __device__ __forceinline__ void operator()(const i32x4 (&acc)[2][2][4][2], const Unit& u, int wr, int wc, int fr, int fq) const {
        const int row0 = u.pm * BM + wr * 64 + fr, col0 = u.pn * BM + wc * 32 + 8 * fq;
        f32x4 sv[2][2]; float srw[8]; f32x4 bv[2][2][2];
#pragma unroll
        for (int bj = 0; bj < 2; ++bj)
#pragma unroll
            for (int n = 0; n < 2; ++n) sv[bj][n] = *(const f32x4*)(sb + col0 + bj * HALF + 4 * n);
#pragma unroll
        for (int g = 0; g < 8; ++g) srw[g] = sa[row0 + (g >> 2) * HALF + (g & 3) * 16];
#define EH_LOAD(slot, g_) do { const size_t off_ = (size_t)(row0 + ((g_) >> 2) * HALF + ((g_) & 3) * 16) * ldc + col0; \
            _Pragma("unroll") for (int bj = 0; bj < 2; ++bj) _Pragma("unroll") for (int n = 0; n < 2; ++n) bv[slot][bj][n] = *(const f32x4*)(base + off_ + bj * HALF + 4 * n); } while (0)
        EH_LOAD(0, 0);
#pragma unroll
        for (int g = 0; g < 8; ++g) { const int ai = g >> 2, m = g & 3, cur = g & 1;
            if (g + 1 < 8) EH_LOAD(cur ^ 1, g + 1);
            bf16_t* rowp = O + (size_t)(row0 + ai * HALF + m * 16) * ldc + col0; const float sr = srw[g];
#pragma unroll
            for (int bj = 0; bj < 2; ++bj) { const f32x4 v0 = bv[cur][bj][0] + __builtin_convertvector(acc[ai][bj][m][0], f32x4) * sv[bj][0] * sr, v1 = bv[cur][bj][1] + __builtin_convertvector(acc[ai][bj][m][1], f32x4) * sv[bj][1] * sr;
                u32x4 w; w.x = cvt_pk_bf16(v0[0], v0[1]); w.y = cvt_pk_bf16(v0[2], v0[3]); w.z = cvt_pk_bf16(v1[0], v1[1]); w.w = cvt_pk_bf16(v1[2], v1[3]);
                *(u32x4*)(rowp + bj * HALF) = w; } }
#undef EH_LOAD
    }
};
struct EpiOut8 {
    static constexpr bool I8 = true; typedef i32x4 acc_t; static constexpr bool PERM = false;
    float* C; int ldc; const bf16_t* base; const float* sa; const float* sb;
    __device__ __forceinline__ void operator()(const i32x4 (&acc)[2][2][4][2], const Unit& u, int wr, int wc, int fr, int fq) const {
        typedef unsigned u32x2 __attribute__((ext_vector_type(2)));
        const int row0 = u.pm * BM + wr * 64 + fr, col0 = u.pn * BM + wc * 32 + 4 * fq;
        f32x4 sv[2][2]; float srw[8]; u32x2 bv[2][2][2];
#pragma unroll
        for (int bj = 0; bj < 2; ++bj)
#pragma unroll
            for (int n = 0; n < 2; ++n) sv[bj][n] = *(const f32x4*)(sb + col0 + bj * HALF + n * 16);
#pragma unroll
        for (int g = 0; g < 8; ++g) srw[g] = sa[row0 + (g >> 2) * HALF + (g & 3) * 16];
#define EO_LOAD(slot, g_) do { const size_t off_ = (size_t)(row0 + ((g_) >> 2) * HALF + ((g_) & 3) * 16) * ldc + col0; \
            _Pragma("unroll") for (int bj = 0; bj < 2; ++bj) _Pragma("unroll") for (int n = 0; n < 2; ++n) bv[slot][bj][n] = *(const u32x2*)(base + off_ + bj * HALF + n * 16); } while (0)
        EO_LOAD(0, 0);
#pragma unroll
        for (int g = 0; g < 8; ++g) { const int ai = g >> 2, m = g & 3, cur = g & 1;
            if (g + 1 < 8) EO_LOAD(cur ^ 1, g + 1);
            const size_t off = (size_t)(row0 + ai * HALF + m * 16) * ldc + col0; const float sr = srw[g];
#pragma unroll
            for (int bj = 0; bj < 2; ++bj)
#pragma unroll
                for (int n = 0; n < 2; ++n) { const u32x2 bq = bv[cur][bj][n]; const f32x4 bb = {bflo(bq.x), bfhi(bq.x), bflo(bq.y), bfhi(bq.y)};
                    *(f32x4*)(C + off + bj * HALF + n * 16) = bb + __builtin_convertvector(acc[ai][bj][m][n], f32x4) * sv[bj][n] * sr; } }
#undef EO_LOAD
    }
};
struct EpiF32_8 {
    static constexpr bool I8 = true; typedef i32x4 acc_t; static constexpr bool PERM = false;
    float* C; int ldc; const float* base; const float* sa; const float* sb;
    __device__ __forceinline__ void operator()(const i32x4 (&acc)[2][2][4][2], const Unit& u, int wr, int wc, int fr, int fq) const {
        const int row0 = u.pm * BM + wr * 64 + fr, col0 = u.pn * BM + wc * 32 + 4 * fq;
        f32x4 sv[2][2]; float srw[8]; f32x4 bv[2][2][2];
#pragma unroll
        for (int bj = 0; bj < 2; ++bj)
#pragma unroll
            for (int n = 0; n < 2; ++n) sv[bj][n] = *(const f32x4*)(sb + col0 + bj * HALF + n * 16);
#pragma unroll
        for (int g = 0; g < 8; ++g) srw[g] = sa[row0 + (g >> 2) * HALF + (g & 3) * 16];
#define EF_LOAD(slot, g_) do { const size_t off_ = (size_t)(row0 + ((g_) >> 2) * HALF + ((g_) & 3) * 16) * ldc + col0; \
            _Pragma("unroll") for (int bj = 0; bj < 2; ++bj) _Pragma("unroll") for (int n = 0; n < 2; ++n) bv[slot][bj][n] = *(const f32x4*)(base + off_ + bj * HALF + n * 16); } while (0)
        EF_LOAD(0, 0);
#pragma unroll
        for (int g = 0; g < 8; ++g) { const int ai = g >> 2, m = g & 3, cur = g & 1;
            if (g + 1 < 8) EF_LOAD(cur ^ 1, g + 1);
            const size_t off = (size_t)(row0 + ai * HALF + m * 16) * ldc + col0; const float sr = srw[g];
#pragma unroll
            for (int bj = 0; bj < 2; ++bj)
#pragma unroll
                for (int n = 0; n < 2; ++n) { const f32x4 o = bv[cur][bj][n] + __builtin_convertvector(acc[ai][bj][m][n], f32x4) * sv[bj][n] * sr;
                    *(f32x4*)(C + off + bj * HALF + n * 16) = o; } }
#undef EF_LOAD
    }
};

template <class T_, class = void> struct is_wide { static constexpr bool value = false; };
template <class T_> struct is_wide<T_, decltype((void)T_::WIDE)> { static constexpr bool value = T_::WIDE; };
template <class Epi, class Sched, bool ALIGN_EPI>
__device__ __forceinline__ void gemm_phase(PG8_LAS unsigned char* lds, const Gemm g, const Sched& S, const Epi& E) {
    constexpr bool I8 = Epi::I8;
    typedef typename Epi::acc_t acc_t;
    int tid = threadIdx.x; asm volatile("" : "+v"(tid));
    const int wid = __builtin_amdgcn_readfirstlane(tid >> 6), lane = tid & 63, wr = wid >> 2, wc = wid & 3, fr = lane & 15, fq = lane >> 4;
    const int nt = g.Kb / 128;
    unsigned voffA[2], voffB[2];
    constexpr bool WIDE = is_wide<Epi>::value;
#pragma unroll
    for (int i = 0; i < 2; ++i) { int R, C; stage_rc(tid * 16 + i * 8192, R, C);
        const int Rb = WIDE ? (64 * (R >> 5) + 16 * ((R & 15) >> 2) + 4 * ((R & 31) >> 4) + (R & 3)) : Epi::PERM ? ((R & ~31) + perm32(R & 31)) : R;
        voffA[i] = (unsigned)(R * g.lda + C * 2); voffB[i] = (unsigned)(Rb * g.ldb + C * 2); }
    const size_t kstep = (size_t)128;
    const size_t hstepA = (size_t)HALF * g.lda, hstepB = (size_t)(WIDE ? 8 : HALF) * g.ldb;
    const size_t tstepA = 2 * hstepA, tstepB = (size_t)BM * g.ldb;
    const unsigned ldsw = (unsigned)wid * 1024u;
    const int aoff = lds_byte(wr * 64 + fr, fq * 8), boff = lds_byte(wc * 32 + fr, fq * 8);
#define PG8_SA(b, h) (((b) * 2 + (h)) * HTB)
#define PG8_SB(b, h) ((4 + (b) * 2 + (h)) * HTB)
#define PG8_STAGE(bufoff, gbase, voff) do { _Pragma("unroll") for (int _i = 0; _i < 2; ++_i) \
        __builtin_amdgcn_global_load_lds((const unsigned*)((const char*)(gbase) + (voff)[_i]), (PG8_LAS unsigned*)(lds + (bufoff) + ldsw + _i * 8192), 16, 0, 0); } while (0)
#define PG8_LDA(dst, b, h) do { _Pragma("unroll") for (int m = 0; m < 4; ++m) _Pragma("unroll") for (int k = 0; k < 2; ++k) dst[m][k] = *(const PG8_LAS bf16x8*)(lds + PG8_SA(b, h) + aoff + m * 2048 + k * 1024); } while (0)
#define PG8_LDB(dst, b, h) do { _Pragma("unroll") for (int n = 0; n < 2; ++n) _Pragma("unroll") for (int k = 0; k < 2; ++k) dst[n][k] = *(const PG8_LAS bf16x8*)(lds + PG8_SB(b, h) + boff + n * 2048 + k * 1024); } while (0)
#define PG8_MMA(ai, bj, At, Bt) do { __builtin_amdgcn_s_setprio(1); _Pragma("unroll") for (int m = 0; m < 4; ++m) _Pragma("unroll") for (int n = 0; n < 2; ++n) _Pragma("unroll") for (int k = 0; k < 2; ++k) { \
        if constexpr (I8) acc[ai][bj][m][n] = __builtin_amdgcn_mfma_i32_16x16x64_i8(__builtin_bit_cast(i32x4, Bt[n][k]), __builtin_bit_cast(i32x4, At[m][k]), acc[ai][bj][m][n], 0, 0, 0); \
        else acc[ai][bj][m][n] = __builtin_amdgcn_mfma_f32_16x16x32_bf16(Bt[n][k], At[m][k], acc[ai][bj][m][n], 0, 0, 0); } __builtin_amdgcn_s_setprio(0); } while (0)
#define PG8_WAIT_V(n) asm volatile("s_waitcnt vmcnt(" #n ")" ::: "memory")
#define PG8_WAIT_L(n) asm volatile("s_waitcnt lgkmcnt(" #n ")" ::: "memory")
#define PG8_BAR __builtin_amdgcn_s_barrier()
#define PG8_SCHED __builtin_amdgcn_sched_barrier(0)
    Unit cur, nxt; int ui = 0;
    if (!S.next(0, cur)) return;
    acc_t acc[2][2][4][2];
#pragma unroll
    for (int a = 0; a < 2; ++a)
#pragma unroll
        for (int b = 0; b < 2; ++b)
#pragma unroll
            for (int m = 0; m < 4; ++m)
#pragma unroll
                for (int n = 0; n < 2; ++n) acc[a][b][m][n] = (acc_t){0, 0, 0, 0};
    bf16x8 At[4][2], B0[2][2], B1[2][2];
    const char* cA = (const char*)g.A + (size_t)cur.pm * tstepA + (size_t)cur.ak; const char* cB = (const char*)g.Bt + (size_t)cur.pn * tstepB;
    PG8_STAGE(PG8_SB(0, 0), cB, voffB); PG8_STAGE(PG8_SB(0, 1), cB + hstepB, voffB); PG8_STAGE(PG8_SA(0, 0), cA, voffA); PG8_STAGE(PG8_SA(0, 1), cA + hstepA, voffA);
    if (wr == 1) PG8_BAR;
    PG8_WAIT_V(2); PG8_BAR;
    PG8_STAGE(PG8_SB(1, 0), cB + kstep, voffB); PG8_STAGE(PG8_SA(1, 0), cA + kstep, voffA); PG8_STAGE(PG8_SB(1, 1), cB + hstepB + kstep, voffB);
    PG8_WAIT_V(6); PG8_BAR;
    for (;;) {
        const bool has_next = S.next(ui + 1, nxt);
        const char* nA = has_next ? (const char*)g.A + (size_t)nxt.pm * tstepA + (size_t)nxt.ak : cA; const char* nB = has_next ? (const char*)g.Bt + (size_t)nxt.pn * tstepB : cB;
        for (int t = 0; t < nt; t += 2) {
            const bool last = (t == nt - 2);
            const char* a1 = cA + (size_t)(t + 1) * kstep;
            const char* a2 = last ? nA : cA + (size_t)(t + 2) * kstep; const char* b2 = last ? nB : cB + (size_t)(t + 2) * kstep;
            const char* a3 = a2 + kstep; const char* b3 = b2 + kstep;
            PG8_LDB(B0, 0, 0); PG8_LDB(B1, 0, 1); PG8_SCHED; PG8_LDA(At, 0, 0); PG8_STAGE(PG8_SA(1, 1), a1 + hstepA, voffA);
            PG8_WAIT_V(8); PG8_WAIT_L(0); PG8_BAR; PG8_MMA(0, 0, At, B0); PG8_MMA(0, 1, At, B1); PG8_BAR; PG8_SCHED;
            PG8_LDA(At, 0, 1); PG8_STAGE(PG8_SB(0, 0), b2, voffB); PG8_STAGE(PG8_SB(0, 1), b2 + hstepB, voffB); PG8_STAGE(PG8_SA(0, 0), a2, voffA);
            PG8_WAIT_V(8); PG8_WAIT_L(0); PG8_BAR; PG8_MMA(1, 0, At, B0); PG8_MMA(1, 1, At, B1); PG8_BAR; PG8_SCHED;
            PG8_LDB(B0, 1, 0); PG8_LDB(B1, 1, 1); PG8_SCHED; PG8_LDA(At, 1, 0); PG8_STAGE(PG8_SA(0, 1), a2 + hstepA, voffA);
            PG8_WAIT_V(8); PG8_WAIT_L(0); PG8_BAR; PG8_MMA(0, 0, At, B0); PG8_MMA(0, 1, At, B1); PG8_BAR; PG8_SCHED;
            PG8_LDA(At, 1, 1); PG8_STAGE(PG8_SB(1, 0), b3, voffB); PG8_STAGE(PG8_SB(1, 1), b3 + hstepB, voffB); PG8_STAGE(PG8_SA(1, 0), a3, voffA);
            PG8_WAIT_V(8); PG8_WAIT_L(0); PG8_BAR; PG8_MMA(1, 0, At, B0); PG8_MMA(1, 1, At, B1); PG8_BAR; PG8_SCHED;
        }
        if constexpr (ALIGN_EPI) { if (wr == 0) PG8_BAR; }
        E(acc, cur, wr, wc, fr, fq);
        if (!has_next) break;
#pragma unroll
        for (int a = 0; a < 2; ++a)
#pragma unroll
            for (int b = 0; b < 2; ++b)
#pragma unroll
                for (int m = 0; m < 4; ++m)
#pragma unroll
                    for (int n = 0; n < 2; ++n) acc[a][b][m][n] = (acc_t){0, 0, 0, 0};
        cur = nxt; cA = nA; cB = nB; ++ui;
        if constexpr (ALIGN_EPI) { if (wr == 1) PG8_BAR; }
    }
    PG8_WAIT_V(0);
    if constexpr (!ALIGN_EPI) { if (wr == 0) PG8_BAR; }
    PG8_BAR;
#undef PG8_SA
#undef PG8_SB
#undef PG8_STAGE
#undef PG8_LDA
#undef PG8_LDB
#undef PG8_MMA
#undef PG8_WAIT_V
#undef PG8_WAIT_L
#undef PG8_BAR
#undef PG8_SCHED
}
}

namespace att {
constexpr int D = 128, LD = 2048, NW = 8, QBLK = 32, KVBLK = 64, QB = NW * QBLK;
constexpr float SCALE = 0.08838834764831845f;
constexpr float THR = 8.f;
constexpr int SHM_V = KVBLK * D * 2, SHM_K = KVBLK * D * 2;
constexpr int SEQ_ = 4096;
__device__ __forceinline__ unsigned f2bf_(float f) { unsigned u = __float_as_uint(f); return (u + 0x7fffu + ((u >> 16) & 1u)) >> 16; }
constexpr int NRING = 4;
constexpr int ATT_LDS_BYTES = NRING * SHM_V + NRING * SHM_K + NW * 64 * 4 + 2 * 32 * 256;
typedef short bf16x8 __attribute__((ext_vector_type(8)));
typedef short s16x4 __attribute__((ext_vector_type(4)));
typedef float f32x16 __attribute__((ext_vector_type(16)));
typedef float f32x4 __attribute__((ext_vector_type(4)));
typedef unsigned u32x4 __attribute__((ext_vector_type(4)));
typedef unsigned short bf16;

#define KSWZ(row, colB) ((row) * 256 + ((colB) ^ (((row) & 7) << 4)))
#define SBAR() __builtin_amdgcn_sched_barrier(0)
__device__ __forceinline__ int v_st(int k, int c) { const int kk = (k & ~0xC) | ((k & 4) << 1) | ((k & 8) >> 1); return ((kk >> 3) * 4 + (c >> 5)) * 512 + ((kk & 7) * 32 + (c & 31)) * 2; }
__device__ __forceinline__ int v_rd_base(int lane) { return ((lane & 3) << 3) | (((lane >> 2) & 3) << 6) | (((lane >> 4) & 1) << 5) | (((lane >> 5) & 1) << 8); }
constexpr int v_rd_off(int d0, int ks, int half) { return d0 * 512 + ks * 4096 + half * 2048; }
__device__ __forceinline__ int crow(int r, int hi) { return (r & 3) + 8 * (r >> 2) + 4 * hi; }
__device__ __forceinline__ unsigned cvtpk(float lo, float hi) { unsigned r; asm volatile("v_cvt_pk_bf16_f32 %0, %1, %2" : "=v"(r) : "v"(lo), "v"(hi)); return r; }
__device__ __forceinline__ bf16x8 load8(const bf16* p) { return *reinterpret_cast<const bf16x8*>(p); }
__device__ __forceinline__ void mask_tile(f32x16& p0, f32x16& p1, int dq) {
    const float NEG = -__builtin_inff();
#pragma unroll
    for (int r = 0; r < 16; ++r) {
        const int c = (r & 3) + 8 * (r >> 2);
        if (dq - c < 0) p0[r] = NEG;
        if (dq - c - 32 < 0) p1[r] = NEG;
    }
}
__device__ __forceinline__ void mask_all(f32x16& p0, f32x16& p1, bool keep) {
    const float NEG = -__builtin_inff();
#pragma unroll
    for (int r = 0; r < 16; ++r) { p0[r] = keep ? p0[r] : NEG; p1[r] = keep ? p1[r] : NEG; }
}
__device__ __forceinline__ void partialSM(f32x16& p0, f32x16& p1, float& m_reg, float& mn, float& alpha) {
    float pmax = p0[0]; for (int r = 1; r < 16; ++r) pmax = fmaxf(pmax, p0[r]); for (int r = 0; r < 16; ++r) pmax = fmaxf(pmax, p1[r]);
    { auto rr = __builtin_amdgcn_permlane32_swap(__float_as_uint(pmax), __float_as_uint(pmax), false, false);
      pmax = fmaxf(__uint_as_float(rr[0]), __uint_as_float(rr[1])); }
    constexpr float C2 = 1.4426950408889634f * SCALE;
    if (__builtin_expect(__all((pmax - m_reg) * SCALE <= THR), 1)) { mn = m_reg; alpha = 1.f; }
    else { mn = fmaxf(m_reg, pmax); alpha = __builtin_amdgcn_exp2f((m_reg - mn) * C2); m_reg = mn; }
    const float mnL = -mn * C2;
    for (int r = 0; r < 16; ++r) p0[r] = fmaf(p0[r], C2, mnL); for (int r = 0; r < 16; ++r) p1[r] = fmaf(p1[r], C2, mnL);
    for (int r = 0; r < 16; ++r) p0[r] = __builtin_amdgcn_exp2f(p0[r]);
}
__device__ __forceinline__ void finishSM(f32x16& p0, f32x16& p1, float alpha, float& l_reg, bf16x8& pa0, bf16x8& pa1, bf16x8& pa2, bf16x8& pa3) {
    for (int r = 0; r < 16; ++r) p1[r] = __builtin_amdgcn_exp2f(p1[r]);
    float ps = 0; for (int r = 0; r < 16; ++r) ps += p0[r]; for (int r = 0; r < 16; ++r) ps += p1[r];
    { auto rr = __builtin_amdgcn_permlane32_swap(__float_as_uint(ps), __float_as_uint(ps), false, false);
      ps = __uint_as_float(rr[0]) + __uint_as_float(rr[1]); }
    l_reg = l_reg * alpha + ps;
#define PK4(P, B_, OUT) do { unsigned a0 = cvtpk(P[B_+0], P[B_+1]), a1 = cvtpk(P[B_+2], P[B_+3]);                          \
        unsigned b0 = cvtpk(P[B_+4], P[B_+5]), b1 = cvtpk(P[B_+6], P[B_+7]);                                             \
        auto r0 = __builtin_amdgcn_permlane32_swap(a0, b0, false, false); auto r1 = __builtin_amdgcn_permlane32_swap(a1, b1, false, false); \
        u32x4 w = {r0[0], r1[0], r0[1], r1[1]}; OUT = *reinterpret_cast<bf16x8*>(&w); } while (0)
    PK4(p0, 0, pa0); PK4(p0, 8, pa1); PK4(p1, 0, pa2); PK4(p1, 8, pa3);
#undef PK4
}
__device__ __forceinline__ void qkt(f32x16& p0, f32x16& p1, const char* K_slot, int r32, int hi, const bf16x8* qr) {
    p0 = f32x16{}; p1 = f32x16{};
    int kb[4];
#pragma unroll
    for (int dd = 0; dd < 4; ++dd) kb[dd] = (int)(uintptr_t)K_slot + KSWZ(r32, (dd * 16 + hi * 8) * 2);
#define KRD(dst, d0) do { asm volatile("ds_read_b128 %0, %1 offset:%2" : "=&v"(dst##0) : "v"(kb[(d0) & 3]), "i"(((d0) >> 2) * 128) : "memory"); \
                          asm volatile("ds_read_b128 %0, %1 offset:%2" : "=&v"(dst##1) : "v"(kb[(d0) & 3]), "i"(((d0) >> 2) * 128 + 32 * 256) : "memory"); } while (0)
#define KWAIT(n, f) asm volatile("s_waitcnt lgkmcnt(" #n ")" : "+v"(f##0), "+v"(f##1) :: "memory")
#define KMMA(f, d0) do { SBAR(); p0 = __builtin_amdgcn_mfma_f32_32x32x16_bf16(f##0, qr[d0], p0, 0, 0, 0); p1 = __builtin_amdgcn_mfma_f32_32x32x16_bf16(f##1, qr[d0], p1, 0, 0, 0); asm volatile("" : "+v"(p0), "+v"(p1)); SBAR(); } while (0)
    bf16x8 fa0, fa1, fb0, fb1, fc0, fc1;
    KRD(fa, 0); KRD(fb, 1);
    KRD(fc, 2); KWAIT(4, fa); KMMA(fa, 0);
    KRD(fa, 3); KWAIT(4, fb); KMMA(fb, 1);
    KRD(fb, 4); KWAIT(4, fc); KMMA(fc, 2);
    KRD(fc, 5); KWAIT(4, fa); KMMA(fa, 3);
    KRD(fa, 6); KWAIT(4, fb); KMMA(fb, 4);
    KRD(fb, 7); KWAIT(4, fc); KMMA(fc, 5);
    KWAIT(2, fa); KMMA(fa, 6);
    KWAIT(0, fb); KMMA(fb, 7);
#undef KRD
#undef KWAIT
#undef KMMA
}
template <bool PIPE>
__device__ __forceinline__ void pv_tile(f32x16* o, int vb0, bf16x8 pa0, bf16x8 pa1, bf16x8 pa2, bf16x8 pa3) {
#define TRRD(dst, off) asm volatile("ds_read_b64_tr_b16 %0, %1 offset:%2" : "=&v"(dst) : "v"(vb0), "i"(off) : "memory")
#define PV_ISSUE(x, g) do { constexpr int b_ = v_rd_off((g) >> 1, 0, 0) + ((g) & 1) * 8192; TRRD(x##l0, b_); TRRD(x##h0, b_ + 2048); TRRD(x##l1, b_ + 4096); TRRD(x##h1, b_ + 6144); } while (0)
#define PV_WAIT(n, x) asm volatile("s_waitcnt lgkmcnt(" #n ")" : "+v"(x##l0), "+v"(x##h0), "+v"(x##l1), "+v"(x##h1) :: "memory")
#define PV_MMA(x, g) do { SBAR(); \
        o[(g) >> 1] = __builtin_amdgcn_mfma_f32_32x32x16_bf16(((g) & 1) ? pa2 : pa0, (bf16x8){x##l0[0], x##l0[1], x##l0[2], x##l0[3], x##h0[0], x##h0[1], x##h0[2], x##h0[3]}, o[(g) >> 1], 0, 0, 0); \
        o[(g) >> 1] = __builtin_amdgcn_mfma_f32_32x32x16_bf16(((g) & 1) ? pa3 : pa1, (bf16x8){x##l1[0], x##l1[1], x##l1[2], x##l1[3], x##h1[0], x##h1[1], x##h1[2], x##h1[3]}, o[(g) >> 1], 0, 0, 0); asm volatile("" : "+v"(o[(g) >> 1])); SBAR(); } while (0)
    if constexpr (!PIPE) {
        s16x4 al0, ah0, al1, ah1;
        PV_ISSUE(a, 0); PV_WAIT(0, a); PV_MMA(a, 0); PV_ISSUE(a, 1); PV_WAIT(0, a); PV_MMA(a, 1); PV_ISSUE(a, 2); PV_WAIT(0, a); PV_MMA(a, 2); PV_ISSUE(a, 3); PV_WAIT(0, a); PV_MMA(a, 3);
        PV_ISSUE(a, 4); PV_WAIT(0, a); PV_MMA(a, 4); PV_ISSUE(a, 5); PV_WAIT(0, a); PV_MMA(a, 5); PV_ISSUE(a, 6); PV_WAIT(0, a); PV_MMA(a, 6); PV_ISSUE(a, 7); PV_WAIT(0, a); PV_MMA(a, 7);
        return;
    }
    s16x4 al0, ah0, al1, ah1, bl0, bh0, bl1, bh1;
    PV_ISSUE(a, 0);
    PV_ISSUE(b, 1); PV_WAIT(4, a); PV_MMA(a, 0);
    PV_ISSUE(a, 2); PV_WAIT(4, b); PV_MMA(b, 1);
    PV_ISSUE(b, 3); PV_WAIT(4, a); PV_MMA(a, 2);
    PV_ISSUE(a, 4); PV_WAIT(4, b); PV_MMA(b, 3);
    PV_ISSUE(b, 5); PV_WAIT(4, a); PV_MMA(a, 4);
    PV_ISSUE(a, 6); PV_WAIT(4, b); PV_MMA(b, 5);
    PV_ISSUE(b, 7); PV_WAIT(4, a); PV_MMA(a, 6);
    PV_WAIT(0, b); PV_MMA(b, 7);
#undef PV_ISSUE
#undef PV_WAIT
#undef PV_MMA
#undef TRRD
}

struct BlockRef { int tok0, h, P0; };
struct Bases { bf16* zq; const bf16* zk; const bf16* zv; const float* kmean; const float* qgain; const float* rcos; const float* rsin; };
#define REF_Q(r) (B.zq + (size_t)((r).tok0 + (r).P0) * LD + (r).h * D)
#define REF_K(r) (B.zk + (size_t)(r).tok0 * LD + (r).h * D)
#define REF_V(r) (B.zv + (size_t)(r).tok0 * LD + (r).h * D)
struct Seam { bf16x8 qr[8]; f32x4 km; int ring; };
#define VMW() asm volatile("s_waitcnt vmcnt(0)" ::: "memory")
#define VMWN(n) asm volatile("s_waitcnt vmcnt(%0)" :: "i"(n) : "memory")
struct DmaOff { int k0, k1, v0, v1; };
__device__ __forceinline__ DmaOff dma_offsets(int wid, int lane) {
    DmaOff d;
    { const int k = 8 * wid + (lane >> 4); d.k0 = k * (LD * 2) + (((lane & 15) * 16) ^ ((k & 7) << 4)); const int k2 = k + 4; d.k1 = k2 * (LD * 2) + (((lane & 15) * 16) ^ ((k2 & 7) << 4)); }
#pragma unroll
    for (int i = 0; i < 2; ++i) { const int q = 2 * wid + i, blk = 2 * q + (lane >> 5), g = lane & 31, kk = (blk >> 2) * 8 + (g >> 2), k = (kk & ~0xC) | ((kk & 4) << 1) | ((kk & 8) >> 1), c = (blk & 3) * 32 + (g & 3) * 8;
        const int off = k * (LD * 2) + c * 2; if (i == 0) d.v0 = off; else d.v1 = off; }
    return d;
}
#define DMA16(gp, lp) __builtin_amdgcn_global_load_lds((const unsigned*)(gp), (__attribute__((address_space(3))) unsigned*)(lp), 16, 0, 0)
#define DMA_TILE(Kp, Vp, k0_, so) do { const char* kb_ = (const char*)(Kp) + (size_t)(k0_) * (LD * 2); const char* vb_ = (const char*)(Vp) + (size_t)(k0_) * (LD * 2); \
        char* kl_ = K_lds + (so) + wid * 2048; char* vl_ = V_lds + (so) + wid * 2048; \
        DMA16(kb_ + DO.k0, kl_); DMA16(kb_ + DO.k1, kl_ + 1024); DMA16(vb_ + DO.v0, vl_); DMA16(vb_ + DO.v1, vl_ + 1024); } while (0)
__device__ __forceinline__ void moba_prime(const Bases& B, const BlockRef& cur, char* lds, Seam& S) {
    int tid = threadIdx.x; asm volatile("" : "+v"(tid));
    const int wid = __builtin_amdgcn_readfirstlane(tid >> 6), lane = tid & 63, r32 = lane & 31, hi = lane >> 5;
    char* V_lds = lds; char* K_lds = lds + NRING * SHM_V; const DmaOff DO = dma_offsets(wid, lane);
    { const bf16* Qp = REF_Q(cur);
    for (int d0 = 0; d0 < 8; ++d0) S.qr[d0] = load8(Qp + (size_t)(wid * QBLK + r32) * LD + d0 * 16 + hi * 8); }
    S.km = *(const f32x4*)(B.kmean + ((size_t)((cur.tok0 / SEQ_) * 16 + cur.h) * 16) * D + (tid >> 5) * D + (tid & 31) * 4);
    { const bf16* Kp = REF_K(cur); const bf16* Vp = REF_V(cur); DMA_TILE(Kp, Vp, 0, 0); DMA_TILE(Kp, Vp, KVBLK, SHM_K); } S.ring = 0;
}
__device__ __forceinline__ void moba_block(const Bases& B, const BlockRef& cur, const BlockRef& nxt, char* lds, Seam& S) {
    int tid = threadIdx.x; asm volatile("" : "+v"(tid));
    const int wid = __builtin_amdgcn_readfirstlane(tid >> 6), lane = tid & 63, r32 = lane & 31, hi = lane >> 5;
    const int NT = cur.P0 / KVBLK + 4;
    const int qlo = cur.P0 + wid * QBLK, qm = qlo + r32 - 4 * hi;
    { const int pos = cur.P0 + wid * QBLK + r32;
      float ss = 0.f;
#pragma unroll
      for (int d0 = 0; d0 < 8; ++d0)
#pragma unroll
          for (int j = 0; j < 8; ++j) { const float f = __uint_as_float((unsigned)(unsigned short)S.qr[d0][j] << 16); ss += f * f; }
      { const auto rr = __builtin_amdgcn_permlane32_swap(__float_as_uint(ss), __float_as_uint(ss), false, false); const unsigned a0 = rr[0], a1 = rr[1]; ss = __uint_as_float(a0) + __uint_as_float(a1); }
      const float rn = 1.f / sqrtf(ss * (1.f / D) + 1e-6f);
#pragma unroll
      for (int d0 = 0; d0 < 4; ++d0) { const int c0 = d0 * 16 + hi * 8;
          const f32x4 ga0 = *(const f32x4*)(B.qgain + c0), ga1 = *(const f32x4*)(B.qgain + c0 + 4), gb0 = *(const f32x4*)(B.qgain + 64 + c0), gb1 = *(const f32x4*)(B.qgain + 64 + c0 + 4);
          const f32x4 cs0 = *(const f32x4*)(B.rcos + pos * 64 + c0), cs1 = *(const f32x4*)(B.rcos + pos * 64 + c0 + 4), sn0 = *(const f32x4*)(B.rsin + pos * 64 + c0), sn1 = *(const f32x4*)(B.rsin + pos * 64 + c0 + 4);
          float oa[8], ob[8];
#pragma unroll
          for (int j = 0; j < 8; ++j) { const float ga = j < 4 ? ga0[j & 3] : ga1[j & 3], gb = j < 4 ? gb0[j & 3] : gb1[j & 3], cc = j < 4 ? cs0[j & 3] : cs1[j & 3], sn = j < 4 ? sn0[j & 3] : sn1[j & 3];
              const float a = __uint_as_float((unsigned)(unsigned short)S.qr[d0][j] << 16) * rn * ga, b = __uint_as_float((unsigned)(unsigned short)S.qr[d0 + 4][j] << 16) * rn * gb;
              oa[j] = a * cc - b * sn; ob[j] = b * cc + a * sn; }
          u32x4 wa = {cvtpk(oa[0], oa[1]), cvtpk(oa[2], oa[3]), cvtpk(oa[4], oa[5]), cvtpk(oa[6], oa[7])}, wb = {cvtpk(ob[0], ob[1]), cvtpk(ob[2], ob[3]), cvtpk(ob[4], ob[5]), cvtpk(ob[6], ob[7])};
          S.qr[d0] = *reinterpret_cast<bf16x8*>(&wa); S.qr[d0 + 4] = *reinterpret_cast<bf16x8*>(&wb); } }
    unsigned selv;
    { const int qb = cur.P0 >> 8;
      if (qb <= 3) selv = (1u << qb) - 1u;
      else {
        char* KMh = lds + NRING * SHM_V + NRING * SHM_K + NW * 64 * 4; char* KMl = KMh + 32 * 256;
        { const int n = tid >> 5, c4 = (tid & 31) * 4;
          const f32x4 v = S.km;
          const unsigned h0 = f2bf_(v[0]), h1 = f2bf_(v[1]), h2 = f2bf_(v[2]), h3 = f2bf_(v[3]);
          const unsigned l0 = f2bf_(v[0] - __uint_as_float(h0 << 16)), l1 = f2bf_(v[1] - __uint_as_float(h1 << 16)), l2 = f2bf_(v[2] - __uint_as_float(h2 << 16)), l3 = f2bf_(v[3] - __uint_as_float(h3 << 16));
          typedef unsigned u32x2_ __attribute__((ext_vector_type(2)));
          *(u32x2_*)(KMh + KSWZ(n, c4 * 2)) = (u32x2_){h0 | (h1 << 16), h2 | (h3 << 16)}; *(u32x2_*)(KMl + KSWZ(n, c4 * 2)) = (u32x2_){l0 | (l1 << 16), l2 | (l3 << 16)}; }
        __syncthreads();
        f32x16 g = f32x16{};
#pragma unroll
        for (int d0 = 0; d0 < 8; ++d0) { const int off = KSWZ(r32, d0 * 32 + hi * 16);
            g = __builtin_amdgcn_mfma_f32_32x32x16_bf16(*reinterpret_cast<const bf16x8*>(KMh + off), S.qr[d0], g, 0, 0, 0);
            g = __builtin_amdgcn_mfma_f32_32x32x16_bf16(*reinterpret_cast<const bf16x8*>(KMl + off), S.qr[d0], g, 0, 0, 0); }
        float dsc[16];
#pragma unroll
        for (int r = 0; r < 8; ++r) { const float f = g[r]; const auto rr = __builtin_amdgcn_permlane32_swap(__float_as_uint(f), __float_as_uint(f), false, false);
            const unsigned a0 = rr[0], a1 = rr[1]; dsc[(r & 3) + 8 * (r >> 2)] = __uint_as_float(a0); dsc[(r & 3) + 8 * (r >> 2) + 4] = __uint_as_float(a1); }
        float b0 = -3e38f, b1 = -3e38f, b2 = -3e38f; int i0 = 0, i1 = 0, i2 = 0;
#pragma unroll
        for (int n = 0; n < 15; ++n) if (n < qb) { const float dd = dsc[n];
            if (dd > b0) { b2 = b1; i2 = i1; b1 = b0; i1 = i0; b0 = dd; i0 = n; }
            else if (dd > b1) { b2 = b1; i2 = i1; b1 = dd; i1 = n; }
            else if (dd > b2) { b2 = dd; i2 = n; } }
        selv = (1u << i0) | (1u << i1) | (1u << i2);
      } }
    char* V_lds = lds; char* K_lds = lds + NRING * SHM_V;
    float* ws = (float*)(lds + NRING * SHM_V + NRING * SHM_K) + wid * 64; float* li_l = ws, * al_l = ws + 32;
    float m_reg = -1e30f, l_reg = 0; f32x16 o[4] = {};
    const DmaOff DO = dma_offsets(wid, lane);
    const int vb0 = (int)(uintptr_t)V_lds + v_rd_base(lane);
    const bf16* Kh = REF_K(cur); const bf16* Vh = REF_V(cur);
    int sK = S.ring * SHM_K, sN = ((S.ring + 1) & 3) * SHM_K, sF = ((S.ring + 2) & 3) * SHM_K, sP = ((S.ring + 3) & 3) * SHM_K;
    if (wid < 4) __builtin_amdgcn_s_setprio(2);
#define ROTATE() do { const int t_ = sP; sP = sK; sK = sN; sN = sF; sF = t_; } while (0)
#define RESC(a) do { if (__any((a) < 1.f)) { if (hi == 0) al_l[r32] = (a); asm volatile("s_waitcnt lgkmcnt(0)" ::: "memory");              \
                     for (int d_ = 0; d_ < 4; ++d_) for (int r = 0; r < 16; ++r) o[d_][r] *= al_l[crow(r, hi)]; } } while (0)
#define KBASE(t) ((t) * KVBLK)
#define MASKT(P0_, P1_, t) do { const int kb_ = KBASE(t); \
        if (kb_ < cur.P0) { const bool keep_ = ((selv >> (kb_ >> 8)) & 1u) != 0u; if (!__all(keep_)) mask_all(P0_, P1_, keep_); } \
        else if (kb_ + KVBLK - 1 > qlo) mask_tile(P0_, P1_, qm - kb_); } while (0)
    f32x16 pA0, pA1, pB0, pB1; float mnA, mnB, alA, alB; bf16x8 pa0, pa1, pa2, pa3;
    VMW(); __syncthreads();
    DMA_TILE(Kh, Vh, KBASE(2), sF);
    SBAR(); qkt(pA0, pA1, K_lds + sK, r32, hi, S.qr); SBAR();
    MASKT(pA0, pA1, 0); partialSM(pA0, pA1, m_reg, mnA, alA);
    ROTATE();
#define HALF_STEP(PX0, PX1, mnX, alX, PY0, PY1, alY, t) do {                                                                  \
        SBAR(); if ((t) + 2 < NT) { DMA_TILE(Kh, Vh, KBASE((t) + 2), sF); SBAR(); }                            \
        qkt(PX0, PX1, K_lds + sK, r32, hi, S.qr);                                                                     \
        finishSM(PY0, PY1, alY, l_reg, pa0, pa1, pa2, pa3); SBAR();                                                           \
        pv_tile<true>(o, vb0 + sP, pa0, pa1, pa2, pa3); MASKT(PX0, PX1, (t)); partialSM(PX0, PX1, m_reg, mnX, alX);           \
        if ((t) + 2 < NT) VMWN(4); else VMW();                         \
        RESC(alX); __syncthreads(); ROTATE(); } while (0)
    for (int t = 1; t + 1 < NT; t += 2) {
        HALF_STEP(pB0, pB1, mnB, alB, pA0, pA1, alA, t);
        HALF_STEP(pA0, pA1, mnA, alA, pB0, pB1, alB, t + 1);
    }
    { SBAR(); qkt(pB0, pB1, K_lds + sK, r32, hi, S.qr); SBAR(); }
    { const bf16* Kn = REF_K(nxt); const bf16* Vn = REF_V(nxt); DMA_TILE(Kn, Vn, 0, sN); DMA_TILE(Kn, Vn, KVBLK, sF); } SBAR();
    { int qrow_ = wid * QBLK + r32; asm volatile("" : "+v"(qrow_));
      const bf16* Qn = REF_Q(nxt) + (size_t)qrow_ * LD + hi * 8;
#pragma unroll
    for (int d0 = 0; d0 < 8; ++d0) S.qr[d0] = load8(Qn + d0 * 16); }
    { int kmo_ = (tid >> 5) * D + (tid & 31) * 4; asm volatile("" : "+v"(kmo_));
      S.km = *(const f32x4*)(B.kmean + ((size_t)((nxt.tok0 / SEQ_) * 16 + nxt.h) * 16) * D + kmo_); }
    SBAR();
    finishSM(pA0, pA1, alA, l_reg, pa0, pa1, pa2, pa3); SBAR();
    pv_tile<true>(o, vb0 + sP, pa0, pa1, pa2, pa3);
    { MASKT(pB0, pB1, NT - 1); partialSM(pB0, pB1, m_reg, mnB, alB); RESC(alB);
      finishSM(pB0, pB1, alB, l_reg, pa0, pa1, pa2, pa3); SBAR(); pv_tile<true>(o, vb0 + sK, pa0, pa1, pa2, pa3); }
    S.ring = __builtin_amdgcn_readfirstlane(sN / SHM_K);
    if (hi == 0) li_l[r32] = l_reg; asm volatile("s_waitcnt lgkmcnt(0)" ::: "memory");
    float rli[16];
#pragma unroll
    for (int r = 0; r < 16; ++r) rli[r] = __builtin_amdgcn_rcpf(li_l[crow(r, hi)]);
    int ocol_ = hi * 4 * LD + r32; asm volatile("" : "+v"(ocol_));
    bf16* Ow = REF_Q(cur) + (size_t)(wid * QBLK) * LD + ocol_;
#pragma unroll
    for (int r = 0; r < 16; ++r) { const int orow = (r & 3) + 8 * (r >> 2);
#pragma unroll
        for (int d0 = 0; d0 < 4; ++d0) { const float v = o[d0][r] * rli[r];
            const float vn = __shfl_xor(v, 1);
            if ((r32 & 1) == 0) *(unsigned*)(Ow + (size_t)orow * LD + d0 * 32) = cvtpk(v, vn); } }
    __builtin_amdgcn_s_setprio(0);
    __syncthreads();
#undef RESC
#undef KBASE
#undef MASKT
#undef HALF_STEP
#undef ROTATE
}
#undef REF_Q
#undef REF_K
#undef REF_V
#undef VMW
#undef VMWN
#undef DMA16
#undef DMA_TILE
#undef KSWZ
#undef SBAR
}

#define XB_TMO      128
#define XB_XCNT(j)  (256  + 64 * (j))
#define XB_XSUB(j)  (1280 + 64 * (j))
#define XB_XGEN(j)  (2304 + 64 * (j))
#define XB_TOP      3328
#define XB_TOPGEN   3392
#define XCD_BAR_WORDS 3456
#define XB_SPIN_CAP (1u << 18)
__device__ __forceinline__ unsigned xb_ld(unsigned* p)              { return __hip_atomic_load(p, __ATOMIC_RELAXED, __HIP_MEMORY_SCOPE_AGENT); }
__device__ __forceinline__ unsigned xb_add(unsigned* p, unsigned v) { return __hip_atomic_fetch_add(p, v, __ATOMIC_RELAXED, __HIP_MEMORY_SCOPE_AGENT); }
__device__ __forceinline__ unsigned xb_xcc_id() { return (unsigned)__builtin_amdgcn_s_getreg((3 << 11) | 20) & 0xFu; }
#define XB_SPIN(cond, bar) do { unsigned _sp = 0; while (cond) { __builtin_amdgcn_s_sleep(1); \
    if ((++_sp & 255u) == 0u) { if (xb_ld(&(bar)[XB_TMO])) break; if (_sp > XB_SPIN_CAP) { atomicAdd(&(bar)[XB_TMO], 1u); break; } } } } while (0)
struct XcdBarrier { unsigned* bar; unsigned x; volatile LAS unsigned* st; };
__device__ __forceinline__ XcdBarrier xcd_barrier_post(unsigned* bar, volatile LAS unsigned* st) {
    XcdBarrier b; b.bar = bar; b.x = xb_xcc_id(); b.st = st;
    if (threadIdx.x == 0) (void)xb_add(&bar[XB_XCNT(b.x)], 1u);
    return b;
}
__device__ __forceinline__ void xcd_barrier_complete(unsigned* bar, unsigned x, unsigned& nloc, unsigned& nx) {
    const unsigned G = gridDim.x * gridDim.y * gridDim.z;
    unsigned sum, cnt, mine, sp = 0u;
    for (;;) {
        sum = 0u; cnt = 0u; mine = 0u;
#pragma unroll
        for (unsigned j = 0; j < 16; ++j) { const unsigned c = xb_ld(&bar[XB_XCNT(j)]); sum += c; cnt += (c > 0u) ? 1u : 0u; mine = (j == x) ? c : mine; }
        if (sum == G) break;
        __builtin_amdgcn_s_sleep(1);
        if ((++sp & 255u) == 0u) { if (xb_ld(&bar[XB_TMO])) break; if (sp > XB_SPIN_CAP) { atomicAdd(&bar[XB_TMO], 1u); break; } }
    }
    nloc = mine > 0u ? mine : 1u; nx = cnt > 0u ? cnt : 1u;
}
__device__ __forceinline__ void xcd_barrier(const XcdBarrier& b) {
    asm volatile("s_waitcnt vmcnt(0)" ::: "memory");
    __syncthreads();
    if (threadIdx.x == 0) {
        unsigned* bar = b.bar;
        __builtin_amdgcn_s_waitcnt(0);
        unsigned nloc = b.st[0], nx = b.st[1];
        if (nloc == 0u) { xcd_barrier_complete(bar, b.x, nloc, nx); b.st[0] = nloc; b.st[1] = nx; }
        const unsigned old = xb_add(&bar[XB_XSUB(b.x)], 1u);
        const unsigned gen = old / nloc;
        if (old + 1u == (gen + 1u) * nloc) {
            __builtin_amdgcn_fence(__ATOMIC_RELEASE, "agent");
            asm volatile("s_waitcnt vmcnt(0)" ::: "memory");
            const unsigned og = xb_add(&bar[XB_TOP], 1u);
            const unsigned tg = og / nx;
            if (og + 1u == (tg + 1u) * nx) xb_add(&bar[XB_TOPGEN], 1u);
            else XB_SPIN(xb_ld(&bar[XB_TOPGEN]) == tg, bar);
            __builtin_amdgcn_fence(__ATOMIC_ACQUIRE, "agent");
            xb_add(&bar[XB_XGEN(b.x)], 1u);
            asm volatile("s_waitcnt vmcnt(0)" ::: "memory");
        } else {
            XB_SPIN(xb_ld(&bar[XB_XGEN(b.x)]) == gen, bar);
            __builtin_amdgcn_fence(__ATOMIC_ACQUIRE, "agent");
            asm volatile("s_waitcnt vmcnt(0)" ::: "memory");
        }
    }
    __syncthreads();
}

__device__ __forceinline__ void p0_transpose_item(const float* W, int K, int N, bf16* WT, int row_off, LAS float* scr, int item, int lane, const float* kscale = nullptr) {
    const int nblk = N / 32, kb = item / nblk, nb = item % nblk, k0 = 64 * kb, n0 = 32 * nb;
    { float t[32]; const float* wp = W + (size_t)(k0 + (lane >> 5)) * N + n0 + (lane & 31);
#pragma unroll
      for (int i = 0; i < 32; ++i) t[i] = __builtin_nontemporal_load(&wp[(size_t)(2 * i) * N]);
#pragma unroll
      for (int i = 0; i < 32; ++i) scr[(2 * i + (lane >> 5)) * 33 + (lane & 31)] = kscale ? t[i] * kscale[k0 + 2 * i + (lane >> 5)] : t[i]; }
    LDS_WAIT(); asm volatile("" ::: "memory");
    const int c = lane & 7;
#pragma unroll
    for (int j = 0; j < 4; ++j) { const int n = (lane >> 3) + 8 * j; const LAS float* s = scr + (8 * c) * 33 + n;
        v4u o; o.x = pk2(s[0 * 33], s[1 * 33]); o.y = pk2(s[2 * 33], s[3 * 33]); o.z = pk2(s[4 * 33], s[5 * 33]); o.w = pk2(s[6 * 33], s[7 * 33]);
        *(GAS v4u*)(WT + (size_t)(row_off + n0 + n) * K + k0 + 8 * c) = o; }
    LDS_WAIT(); asm volatile("" ::: "memory");
}
#define PK_CE(a, b) do { const unsigned x_ = (a), y_ = (b); (a) = x_ > y_ ? x_ : y_; (b) = x_ > y_ ? y_ : x_; } while (0)
template <int B> __device__ __forceinline__ void pk_merge16(unsigned (&u)[64]) {
#pragma unroll
    for (int j = 8; j > 0; j >>= 1)
#pragma unroll
        for (int i = 0; i < 16; ++i) { const int l = i ^ j; if (l > i) PK_CE(u[B + i], u[B + l]); }
}
template <int B> __device__ __forceinline__ void pk_sort16(unsigned (&u)[64]) {
#pragma unroll
    for (int k = 2; k <= 16; k <<= 1)
#pragma unroll
        for (int j = k >> 1; j > 0; j >>= 1)
#pragma unroll
            for (int i = 0; i < 16; ++i) { const int l = i ^ j; if (l > i) { if ((i & k) == 0) PK_CE(u[B + i], u[B + l]); else PK_CE(u[B + l], u[B + i]); } }
}
template <int X, int Y> __device__ __forceinline__ void pk_top16(unsigned (&u)[64]) {
#pragma unroll
    for (int i = 0; i < 16; ++i) u[X + i] = u[X + i] > u[Y + 15 - i] ? u[X + i] : u[Y + 15 - i];
    pk_merge16<X>(u);
}
__device__ __forceinline__ void rms_row_to_bf16(const float* xrow, const float* gain, bf16* orow, int lane) {
    const GAS f32x4* xr = (const GAS f32x4*)xrow + lane; const GAS f32x4* gr = (const GAS f32x4*)gain + lane;
    f32x4 v[16]; float s = 0.f;
#pragma unroll
    for (int j = 0; j < 16; ++j) { v[j] = xr[64 * j]; s += (v[j].x * v[j].x + v[j].y * v[j].y) + (v[j].z * v[j].z + v[j].w * v[j].w); }
    const float r = 1.f / sqrtf(wave_sum(s) * (1.f / DM) + EPS);
    GAS v2u* o8 = (GAS v2u*)orow + lane;
#pragma unroll
    for (int j = 0; j < 16; ++j) { const f32x4 g = gr[64 * j]; v2u w; w.x = pk2(v[j].x * r * g.x, v[j].y * r * g.y); w.y = pk2(v[j].z * r * g.z, v[j].w * r * g.w); o8[64 * j] = w; }
}
__device__ __forceinline__ float wave_max(float v) {
#pragma unroll
    for (int o = 1; o < 64; o <<= 1) v = fmaxf(v, __shfl_xor(v, o));
    return v;
}
__device__ __forceinline__ unsigned q8x4(f32x4 v, float inv) {
    const int a = (int)__builtin_rintf(v.x * inv), b = (int)__builtin_rintf(v.y * inv), c = (int)__builtin_rintf(v.z * inv), d = (int)__builtin_rintf(v.w * inv);
    return (unsigned)(a & 255) | ((unsigned)(b & 255) << 8) | ((unsigned)(c & 255) << 16) | ((unsigned)d << 24);
}
__device__ __forceinline__ void rms_row_quant(const float* xrow, const float* gain, const float* kscale, signed char* o8, float* scale_out, bf16* obf, int lane) {
    const GAS f32x4* xr = (const GAS f32x4*)xrow + lane; const GAS f32x4* gr = (const GAS f32x4*)gain + lane; const GAS f32x4* kr = (const GAS f32x4*)kscale + lane;
    f32x4 v[16]; float s = 0.f;
#pragma unroll
    for (int j = 0; j < 16; ++j) { v[j] = __builtin_nontemporal_load(&xr[64 * j]); s += (v[j].x * v[j].x + v[j].y * v[j].y) + (v[j].z * v[j].z + v[j].w * v[j].w); }
    const float r = 1.f / sqrtf(wave_sum(s) * (1.f / DM) + EPS); float am = 0.f;
#pragma unroll
    for (int j = 0; j < 16; ++j) { f32x4 g = gr[64 * j]; if (kscale) g = g * kr[64 * j]; v[j] = v[j] * r * g; am = fmaxf(am, fmaxf(fmaxf(fabsf(v[j].x), fabsf(v[j].y)), fmaxf(fabsf(v[j].z), fabsf(v[j].w)))); }
    am = fmaxf(wave_max(am), 1e-30f); const float inv = 127.f / am;
    if (lane == 0) *scale_out = am * (1.f / 127.f);
    GAS unsigned* o4 = (GAS unsigned*)o8 + lane;
#pragma unroll
    for (int j = 0; j < 16; ++j) o4[64 * j] = q8x4(v[j], inv);
    if (obf) { GAS v2u* ob = (GAS v2u*)obf + lane;
#pragma unroll
        for (int j = 0; j < 16; ++j) { v2u w; w.x = pk2(v[j].x, v[j].y); w.y = pk2(v[j].z, v[j].w); ob[64 * j] = w; } }
}
template <bool NTS = false> __device__ __forceinline__ void row_quant(const float* xrow, signed char* o8, float* scale_out, int lane) {
    const GAS f32x4* xr = (const GAS f32x4*)xrow + lane; f32x4 v[16]; float am = 0.f;
#pragma unroll
    for (int j = 0; j < 16; ++j) { v[j] = __builtin_nontemporal_load(&xr[64 * j]); am = fmaxf(am, fmaxf(fmaxf(fabsf(v[j].x), fabsf(v[j].y)), fmaxf(fabsf(v[j].z), fabsf(v[j].w)))); }
    am = fmaxf(wave_max(am), 1e-30f); const float inv = 127.f / am;
    if (lane == 0) *scale_out = am * (1.f / 127.f);
    GAS unsigned* o4 = (GAS unsigned*)o8 + lane;
#pragma unroll
    for (int j = 0; j < 16; ++j) { if constexpr (NTS) __builtin_nontemporal_store(q8x4(v[j], inv), &o4[64 * j]); else o4[64 * j] = q8x4(v[j], inv); }
}
__device__ __forceinline__ void rms_row_quant_h16(const bf16* hrow, const float* gain, signed char* o8, float* scale_out, float* rinv_out, int lane) {
    const GAS v4u* hr = (const GAS v4u*)hrow + lane; const GAS f32x4* gr = (const GAS f32x4*)gain + 2 * lane;
    float v[8][8]; float s = 0.f;
#pragma unroll
    for (int j = 0; j < 8; ++j) { const v4u w = hr[64 * j]; v[j][0] = bflo(w.x); v[j][1] = bfhi(w.x); v[j][2] = bflo(w.y); v[j][3] = bfhi(w.y); v[j][4] = bflo(w.z); v[j][5] = bfhi(w.z); v[j][6] = bflo(w.w); v[j][7] = bfhi(w.w);
#pragma unroll
        for (int e = 0; e < 8; ++e) s += v[j][e] * v[j][e]; }
    const float r = 1.f / sqrtf(wave_sum(s) * (1.f / DM) + EPS); float am = 0.f;
#pragma unroll
    for (int j = 0; j < 8; ++j) { const f32x4 ga = gr[128 * j], gb = gr[128 * j + 1]; const float gg[8] = {ga.x, ga.y, ga.z, ga.w, gb.x, gb.y, gb.z, gb.w};
#pragma unroll
        for (int e = 0; e < 8; ++e) { v[j][e] = v[j][e] * r * gg[e]; am = fmaxf(am, fabsf(v[j][e])); } }
    am = fmaxf(wave_max(am), 1e-30f); const float inv = 127.f / am;
    if (lane == 0) { *scale_out = am * (1.f / 127.f); *rinv_out = r; }
    GAS v2u* o2 = (GAS v2u*)o8 + lane;
#pragma unroll
    for (int j = 0; j < 8; ++j) { v2u o; o.x = q8x4((f32x4){v[j][0], v[j][1], v[j][2], v[j][3]}, inv); o.y = q8x4((f32x4){v[j][4], v[j][5], v[j][6], v[j][7]}, inv); o2[64 * j] = o; }
}
template <int NCH> __device__ __forceinline__ void row_quant_bf16(const bf16* src, const float* kscale, signed char* o8, float* scale_out, int lane) {
    const GAS v4u* sr = (const GAS v4u*)src + lane; const GAS f32x4* kr = (const GAS f32x4*)kscale + 2 * lane; float v[NCH][8]; float am = 0.f;
#pragma unroll
    for (int j = 0; j < NCH; ++j) { const v4u w = sr[64 * j]; const f32x4 ka = kr[128 * j], kb = kr[128 * j + 1];
        v[j][0] = bflo(w.x) * ka.x; v[j][1] = bfhi(w.x) * ka.y; v[j][2] = bflo(w.y) * ka.z; v[j][3] = bfhi(w.y) * ka.w; v[j][4] = bflo(w.z) * kb.x; v[j][5] = bfhi(w.z) * kb.y; v[j][6] = bflo(w.w) * kb.z; v[j][7] = bfhi(w.w) * kb.w;
#pragma unroll
        for (int e = 0; e < 8; ++e) am = fmaxf(am, fabsf(v[j][e])); }
    am = fmaxf(wave_max(am), 1e-30f); const float inv = 127.f / am;
    if (lane == 0) *scale_out = am * (1.f / 127.f);
    GAS v2u* o2 = (GAS v2u*)o8 + lane;
#pragma unroll
    for (int j = 0; j < NCH; ++j) { v2u o; o.x = q8x4((f32x4){v[j][0], v[j][1], v[j][2], v[j][3]}, inv); o.y = q8x4((f32x4){v[j][4], v[j][5], v[j][6], v[j][7]}, inv); o2[64 * j] = o; }
}
__device__ __forceinline__ void premix_quant_run8(const bf16* zp, int row0, signed char* o8, float* scale_out, int lane) {
    const int t0 = row0 & (SEQ - 1);
    const bf16* base = zp + (size_t)row0 * 2048 + lane * 8;
    float sum[4][8];
#pragma unroll
    for (int j = 0; j < 4; ++j) {
#pragma unroll
        for (int e = 0; e < 8; ++e) sum[j][e] = 0.f;
        const int w = 2 << j, n = t0 < w ? t0 : w;
#pragma unroll 1
        for (int k = 1; k <= n; ++k) { const v4u v = *(const GAS v4u*)(base - (size_t)k * 2048 + 512 * j);
            sum[j][0] += bflo(v.x); sum[j][1] += bfhi(v.x); sum[j][2] += bflo(v.y); sum[j][3] += bfhi(v.y); sum[j][4] += bflo(v.z); sum[j][5] += bfhi(v.z); sum[j][6] += bflo(v.w); sum[j][7] += bfhi(v.w); } }
#pragma unroll 1
    for (int i = 0; i < 8; ++i) { const int t = t0 + i; const bf16* rp = base + (size_t)i * 2048;
        float out[4][8]; float am = 0.f;
#pragma unroll
        for (int j = 0; j < 4; ++j) { const int w = 2 << j; const v4u v = *(const GAS v4u*)(rp + 512 * j);
            const float cur[8] = {bflo(v.x), bfhi(v.x), bflo(v.y), bfhi(v.y), bflo(v.z), bfhi(v.z), bflo(v.w), bfhi(v.w)};
#pragma unroll
            for (int e = 0; e < 8; ++e) sum[j][e] += cur[e];
            if (t - w >= 0) { const v4u o = *(const GAS v4u*)(rp - (size_t)w * 2048 + 512 * j);
                sum[j][0] -= bflo(o.x); sum[j][1] -= bfhi(o.x); sum[j][2] -= bflo(o.y); sum[j][3] -= bfhi(o.y); sum[j][4] -= bflo(o.z); sum[j][5] -= bfhi(o.z); sum[j][6] -= bflo(o.w); sum[j][7] -= bfhi(o.w); }
            const float rc = 1.f / (float)(t + 1 < w ? t + 1 : w);
#pragma unroll
            for (int e = 0; e < 8; ++e) { out[j][e] = sum[j][e] * rc - cur[e]; am = fmaxf(am, fabsf(out[j][e])); } }
        am = fmaxf(wave_max(am), 1e-30f); const float inv = 127.f / am;
        if (lane == 0) scale_out[i] = am * (1.f / 127.f);
        GAS v2u* o2 = (GAS v2u*)(o8 + (size_t)i * 2048) + lane;
#pragma unroll
        for (int j = 0; j < 4; ++j) { v2u o; o.x = q8x4((f32x4){out[j][0], out[j][1], out[j][2], out[j][3]}, inv); o.y = q8x4((f32x4){out[j][4], out[j][5], out[j][6], out[j][7]}, inv); o2[64 * j] = o; } }
}
__device__ __forceinline__ void warm_sweep(const void* base, size_t bytes, int gw, int NGW, int lane) {
    const size_t per = bytes / (size_t)NGW / 1024;
    const GAS v4u* p = (const GAS v4u*)base + ((size_t)gw * per) * 64 + lane; unsigned acc = 0u;
#pragma unroll 8
    for (size_t i = 0; i < per; ++i) { const v4u t = p[i * 64]; acc ^= t.x ^ t.y ^ t.z ^ t.w; }
    asm volatile("" :: "v"(acc));
}
__device__ __forceinline__ void row_quant_wg(const f32x4 (&v)[8], signed char* o8, float* scale_out, LAS float* red, int tid, int lane, int wave) {
    float am = 0.f;
#pragma unroll
    for (int j = 0; j < 8; ++j) am = fmaxf(am, fmaxf(fmaxf(fabsf(v[j].x), fabsf(v[j].y)), fmaxf(fabsf(v[j].z), fabsf(v[j].w))));
    am = wave_max(am);
    if (lane == 0) red[wave] = am;
    LDS_WAIT(); __syncthreads();
    am = fmaxf(fmaxf(fmaxf(red[0], red[1]), fmaxf(red[2], red[3])), fmaxf(fmaxf(red[4], red[5]), fmaxf(red[6], red[7])));
    am = fmaxf(am, 1e-30f); const float inv = 127.f / am;
    if (tid == 0) *scale_out = am * (1.f / 127.f);
    GAS unsigned* o4 = (GAS unsigned*)o8 + tid;
#pragma unroll
    for (int j = 0; j < 8; ++j) o4[512 * j] = q8x4(v[j], inv);
    __syncthreads();
}
template <bool NTS = false> __device__ __forceinline__ void tr8_item(const signed char* W8, int K, int N, signed char* WT, LAS unsigned* scr, int item, int lane) {
    const int nblk = N / 128, kb = item / nblk, nb = item % nblk, k0 = 128 * kb, n0 = 128 * nb, nq = lane & 31, kh = lane >> 5;
    unsigned r[64]; const signed char* src = W8 + (size_t)(k0 + 64 * kh) * N + n0 + 4 * nq;
#pragma unroll
    for (int i = 0; i < 64; ++i) r[i] = __builtin_nontemporal_load((const GAS unsigned*)(src + (size_t)i * N));
#pragma unroll
    for (int g = 0; g < 16; ++g)
#pragma unroll
        for (int c = 0; c < 4; ++c)
            scr[(4 * nq + c) * 33 + 16 * kh + g] = ((r[4 * g] >> (8 * c)) & 255u) | (((r[4 * g + 1] >> (8 * c)) & 255u) << 8) | (((r[4 * g + 2] >> (8 * c)) & 255u) << 16) | (((r[4 * g + 3] >> (8 * c)) & 255u) << 24);
    LDS_WAIT(); asm volatile("" ::: "memory");
    const int ch = lane & 7;
#pragma unroll
    for (int j = 0; j < 16; ++j) { const int n = (lane >> 3) + 8 * j; const LAS unsigned* sp = scr + n * 33 + 4 * ch;
        v4u o; o.x = sp[0]; o.y = sp[1]; o.z = sp[2]; o.w = sp[3];
        if constexpr (NTS) __builtin_nontemporal_store(o, (GAS v4u*)(WT + (size_t)(n0 + n) * K + k0 + 16 * ch)); else *(GAS v4u*)(WT + (size_t)(n0 + n) * K + k0 + 16 * ch) = o; }
    LDS_WAIT(); asm volatile("" ::: "memory");
}
__device__ __forceinline__ void sincos_red(float angf, float& sn, float& cs) {
    const double a = (double)angf;
    const double kd = __builtin_rint(a * 0.63661977236758134308);
    const double r = __builtin_fma(-kd, 1.57079632679489661923, a);
    const int q = (int)kd & 3;
    const double r2 = r * r;
    const double sp = r * (1.0 + r2 * (-1.0 / 6 + r2 * (1.0 / 120 + r2 * (-1.0 / 5040 + r2 * (1.0 / 362880 + r2 * (-1.0 / 39916800))))));
    const double cp = 1.0 + r2 * (-0.5 + r2 * (1.0 / 24 + r2 * (-1.0 / 720 + r2 * (1.0 / 40320 + r2 * (-1.0 / 3628800 + r2 * (1.0 / 479001600))))));
    const double s4 = (q & 1) ? cp : sp, c4 = (q & 1) ? sp : cp;
    sn = (float)((q & 2) ? -s4 : s4); cs = (float)(((q + 1) & 2) ? -c4 : c4);
}
__device__ __forceinline__ void wave_argmax(float& v, int& i) {
#pragma unroll
    for (int o = 1; o < 64; o <<= 1) { const float ov = __shfl_xor(v, o); const int oi = __shfl_xor(i, o); const bool take = (ov > v) || (ov == v && oi < i); v = take ? ov : v; i = take ? oi : i; }
}

struct Args { const float* in[15]; float* out; unsigned char* ws; int ph_lo, ph_hi; };
__global__ void __launch_bounds__(NWAVES * 64, 2) fwd_kernel(Args args) {
    extern __shared__ __attribute__((aligned(16))) unsigned char lds_raw[];
    LAS unsigned char* lds = (LAS unsigned char*)lds_raw;
    volatile LAS unsigned* MISC = (volatile LAS unsigned*)(lds + MISC_OFF);
    const int G = gridDim.x;
    const int vcu = (G % 8 == 0) ? ((int)blockIdx.x % 8) * (G / 8) + (int)blockIdx.x / 8 : (int)blockIdx.x;
#define PH_BEGIN \
    int tid = threadIdx.x; asm volatile("" : "+v"(tid)); \
    const int lane = tid & 63, wave = __builtin_amdgcn_readfirstlane(tid >> 6); \
    const int gw = vcu * NWAVES + wave, NGW = G * NWAVES; const int gt = vcu * (NWAVES * 64) + tid, NGT = G * NWAVES * 64; \
    unsigned char* ws = args.ws; \
    const float* x = args.in[0]; const float* norm_mix = args.in[1]; const float* w_in = args.in[2]; const float* pool_w = args.in[3]; const float* pool_scale = args.in[4]; \
    const float* q_norm = args.in[5]; const float* k_norm = args.in[6]; const float* w_pool_out = args.in[7]; const float* w_attn_out = args.in[8]; const float* w_o = args.in[9]; \
    const float* norm_ffn = args.in[10]; const float* peer_wq = args.in[11]; const float* peer_sub = args.in[12]; const float* peer_u = args.in[13]; const float* peer_v = args.in[14]; \
    float* out = args.out; \
    float* rope_cos = (float*)(ws + WS_ROPE); float* rope_sin = rope_cos + SEQ * 64; \
    float* kmean = (float*)(ws + WS_KMEAN); \
    unsigned* selbuf = (unsigned*)(ws + WS_SEL); \
    int* pidx = (int*)(ws + WS_PIDX); float* pgate = (float*)(ws + WS_PG); \
    bf16* poolwT = (bf16*)(ws + WS_POOLW); signed char* wpo8 = (signed char*)(ws + WS_WPO); signed char* wao8 = (signed char*)(ws + WS_WAO); signed char* wo8 = (signed char*)(ws + WS_WO); bf16* wqT = (bf16*)(ws + WS_WQ); \
    signed char* yp8 = (signed char*)(ws + WS_YP8); signed char* ya8 = (signed char*)(ws + WS_YA8); signed char* mrg8 = (signed char*)(ws + WS_YPRE); \
    signed char* u8 = (signed char*)(ws + WS_U8); signed char* vT8 = (signed char*)(ws + WS_VT8); signed char* win8 = (signed char*)(ws + WS_WIN8); signed char* xn8 = (signed char*)(ws + WS_XN8); \
    signed char* hn8 = (signed char*)(ws + WS_WIN8); signed char* act8 = (signed char*)(ws + WS_ACT8); \
    float* sa_x = (float*)(ws + WS_SCALE); float* sa_hn = sa_x + T; float* sa_act = sa_hn + T; float* sb_win = sa_act + T; float* sb_u = sb_win + INW; float* sb_v = sb_u + PEER_E; \
    float* sb_wo = sb_v + DM; float* sb_wpo = sb_wo + DM; float* sb_wao = sb_wpo + DM; float* sa_yp = sb_wao + DM; float* sa_ya = sa_yp + T; float* sa_m = sa_ya + T; \
    float* sk_win = sa_m + T; float* sk_v = sk_win + DM; float* sk_wo = sk_v + PEER_E; float* sk_wpo = sk_wo + DM; float* sk_wao = sk_wpo + PW; float* rinv_h = sk_wao + PW; float* sb_wq = rinv_h + T; signed char* wq8 = (signed char*)(ws + WS_WPO);   \
    signed char* win8r = (signed char*)(ws + WS_Z); signed char* v8r = win8r + (size_t)64 * MiB; signed char* wo8r = v8r + (size_t)64 * MiB; signed char* wpo8r = wo8r + (size_t)16 * MiB; signed char* wao8r = wpo8r + (size_t)8 * MiB; \
    unsigned* cmax_win = (unsigned*)(ws + WS_CTL + CTL_CMAX_WIN); unsigned* cmax_v = (unsigned*)(ws + WS_CTL + CTL_CMAX_V); \
    unsigned* cmax_wo = (unsigned*)(ws + WS_CTL + CTL_CMAX_WO); unsigned* cmax_wpo = (unsigned*)(ws + WS_CTL + CTL_CMAX_WPO); unsigned* cmax_wao = (unsigned*)(ws + WS_CTL + CTL_CMAX_WAO); \
    bf16* ypre = (bf16*)(ws + WS_YPRE); bf16* hn = (bf16*)(ws + WS_XN8); \
    bf16* mrg = (bf16*)(ws + WS_MRG); float* pq = (float*)(ws + WS_MRG); \
    bf16* Z = (bf16*)(ws + WS_Z); bf16* act = (bf16*)(ws + WS_Z); bf16* h16 = (bf16*)(ws + WS_H16); \
    bf16* wpoST = (bf16*)(ws + WS_WPO); bf16* poolw16 = (bf16*)(ws + WS_POOLW); bf16* wcombT = (bf16*)(ws + WS_MRG); signed char* wcomb8 = (signed char*)(ws + WS_WAO) + (size_t)8 * MiB; \
    (void)wpoST; (void)poolw16; (void)wcombT; (void)wcomb8; \
    bf16* zp = Z; bf16* zq = Z + ZSLOT; bf16* zk = Z + 2 * ZSLOT; bf16* zv = Z + 3 * ZSLOT; bf16* ypool = Z; \
    (void)lane; (void)wave; (void)gw; (void)NGW; (void)gt; (void)NGT; (void)x; (void)norm_mix; (void)w_in; (void)pool_w; (void)pool_scale; (void)q_norm; (void)k_norm; (void)w_pool_out; \
    (void)w_attn_out; (void)w_o; (void)norm_ffn; (void)peer_wq; (void)peer_sub; (void)peer_u; (void)peer_v; (void)out; (void)rope_cos; (void)rope_sin; (void)kmean; (void)selbuf; (void)pidx; \
    (void)pgate; (void)poolwT; (void)wpo8; (void)wao8; (void)wo8; (void)wqT; (void)yp8; (void)ya8; (void)mrg8; (void)sb_wo; (void)sb_wpo; (void)sb_wao; (void)sa_yp; (void)sa_ya; (void)sa_m; (void)cmax_wo; (void)cmax_wpo; (void)cmax_wao; (void)u8; (void)vT8; (void)win8; (void)xn8; (void)hn8; (void)act8; (void)sa_x; (void)sa_hn; (void)sa_act; (void)sb_win; (void)sb_u; (void)sb_v; \
    (void)rinv_h; (void)sb_wq; (void)wq8; (void)h16; (void)sk_win; (void)sk_v; (void)sk_wo; (void)sk_wpo; (void)sk_wao; (void)win8r; (void)v8r; (void)wo8r; (void)wpo8r; (void)wao8r; (void)cmax_win; (void)cmax_v; (void)ypre; (void)hn; (void)mrg; (void)pq; (void)act; (void)zp; (void)zq; (void)zk; (void)zv; (void)ypool
    gu32* ctl = (gu32*)(args.ws + WS_CTL);
    for (int u = threadIdx.x; u < (LDS_BYTES - LDSCTL_OFF) / 4; u += NWAVES * 64) ((LAS unsigned*)(lds + LDSCTL_OFF))[u] = 0u;
    __syncthreads();
    XcdBarrier bar; bar.bar = (unsigned*)(ctl + CW_BAR); bar.x = 0; bar.st = nullptr;
    if (MK_N_LAUNCHES == 1) bar = xcd_barrier_post((unsigned*)(ctl + CW_BAR), MISC + 8);
    const int lo = args.ph_lo, hi = args.ph_hi;
#ifndef PH_EN
#define PH_EN 0xffffffffu
#endif
#define IN(k) (((PH_EN >> (k)) & 1u) && lo <= (k) && (k) < hi)
#define GRID_BAR(k) do { if (IN(k) && IN((k) + 1)) xcd_barrier(bar); } while (0)

    for (int rep0 = 0; rep0 < (((PH_REP >> 0) & 1u) ? 2 : 1); ++rep0)
    if (IN(0)) { PH_BEGIN;
        LAS float* scr = (LAS float*)(lds + wave * 16384);
        { LAS float* red = (LAS float*)(lds + 131072);
          f32x4 cv[8], nv[8];
          if (vcu < DM) {
#pragma unroll
              for (int j = 0; j < 8; ++j) nv[j] = __builtin_nontemporal_load((const GAS f32x4*)(w_in + (size_t)vcu * INW) + tid + 512 * j); }
          for (int k = vcu; k < DM; k += G) {
#pragma unroll
              for (int j = 0; j < 8; ++j) cv[j] = nv[j];
              if (k + G < DM) {
#pragma unroll
                  for (int j = 0; j < 8; ++j) nv[j] = __builtin_nontemporal_load((const GAS f32x4*)(w_in + (size_t)(k + G) * INW) + tid + 512 * j); }
              row_quant_wg(cv, win8r + (size_t)k * INW, sk_win + k, red, tid, lane, wave); } }
        for (int r = gw; r < PEER_E + DM + PW + AW; r += NGW) {
            if (r < PEER_E) row_quant(peer_v + (size_t)r * DM, v8r + (size_t)r * DM, sk_v + r, lane);
            else if (r < PEER_E + DM) { const int k = r - PEER_E; row_quant(w_o + (size_t)k * DM, wo8r + (size_t)k * DM, sk_wo + k, lane); }
            else if (r < PEER_E + DM + PW) { }
            else { const int k = r - PEER_E - DM - PW; row_quant(w_attn_out + (size_t)k * DM, wao8r + (size_t)k * DM, sk_wao + k, lane); } }
        constexpr int I_WQ = (DM / 64) * (2048 / 32), I_POT = (PW / 64) * (DM / 32);
        for (int it = gw; it < I_WQ + I_POT; it += NGW) {
            if (it < I_WQ) p0_transpose_item(peer_wq, DM, 2048, wqT, 0, scr, it, lane);
            else p0_transpose_item(w_pool_out, PW, DM, wpoST, 0, scr, it - I_WQ, lane, pool_scale);
        }
        for (int i = gt; i < 4 * 512 * 512 / 8; i += NGT) {
            const GAS f32x4* sp = (const GAS f32x4*)pool_w + 2 * i; const f32x4 a = sp[0], b = sp[1];
            v4u o; o.x = pk2(a.x, a.y); o.y = pk2(a.z, a.w); o.z = pk2(b.x, b.y); o.w = pk2(b.z, b.w); *((GAS v4u*)poolw16 + i) = o; }
        for (int e = gw; e < PEER_E; e += NGW) row_quant<true>(peer_u + (size_t)e * DM, u8 + (size_t)e * DM, sb_u + e, lane);
        for (int i = gt; i < SEQ * 64; i += NGT) { const int pos = i >> 6, j = i & 63;
            const float inv = (float)exp(-(double)j * (1.0 / 64.0) * 9.210340371976184);
            const float ang = (float)pos * inv; float sn, cs; sincos_red(ang, sn, cs); rope_cos[i] = cs; rope_sin[i] = sn; }
        for (int i = gt; i < INW + 3 * DM; i += NGT) { float* sb = i < INW ? sb_win + i : i < INW + DM ? sb_v + (i - INW) : i < INW + 2 * DM ? sb_wo + (i - INW - DM) : sb_wao + (i - INW - 2 * DM);
            *sb = 1.f; }
    }
    GRID_BAR(0);

    for (int rep1 = 0; rep1 < (((PH_REP >> 1) & 1u) ? 2 : 1); ++rep1)
    if (IN(1)) { PH_BEGIN;
        LAS unsigned* scr = (LAS unsigned*)(lds + wave * 16896);
        constexpr int I_WIN = (DM / 128) * (INW / 128), I_V = (PEER_E / 128) * (DM / 128), I_O = (DM / 128) * (DM / 128), I_PO = (PW / 128) * (DM / 128);
        for (int it = gw; it < I_WIN + I_V + I_O + I_PO; it += NGW) { int r = it;
            if (r < I_WIN) { tr8_item(win8r, DM, INW, win8, scr, r, lane); continue; } r -= I_WIN;
            if (r < I_V) { tr8_item<true>(v8r, PEER_E, DM, vT8, scr, r, lane); continue; } r -= I_V;
            if (r < I_O) { tr8_item(wo8r, DM, DM, wo8, scr, r, lane); continue; } r -= I_O;
            tr8_item(wao8r, AW, DM, wao8, scr, r, lane); }
        for (int m = gw; m < T; m += NGW) rms_row_quant(x + (size_t)m * DM, norm_mix, sk_win, xn8 + (size_t)m * DM, sa_x + m, nullptr, lane);
        __syncthreads();
        {
            pg8::Gemm g{wpoST, poolw16, 512 * 2, 2048 * 2, 512 * 2}; pg8::PoolOrder S; S.init(DM, PW, G, (int)blockIdx.x);
            pg8::EpiBf16 E{wcombT, 2048};
            pg8::gemm_phase<pg8::EpiBf16, pg8::PoolOrder, true>(lds, g, S, E);
        }
    }
    GRID_BAR(1);

    for (int rep2 = 0; rep2 < (((PH_REP >> 2) & 1u) ? 2 : 1); ++rep2)
    if (IN(2)) { PH_BEGIN;
        pg8::Gemm g{xn8, win8, DM, DM, DM}; pg8::StaticOrder S; S.init(T, INW, G, (int)blockIdx.x);
        pg8::EpiZ8 E{Z, sa_x, sb_win};
        pg8::gemm_phase<pg8::EpiZ8, pg8::StaticOrder, PG8_ALIGN>(lds, g, S, E);
    }
    GRID_BAR(2);

    if (IN(3)) { PH_BEGIN;
        for (int n = gw; n < DM; n += NGW) row_quant_bf16<4>(wcombT + (size_t)n * 2048, sb_win  , wcomb8 + (size_t)n * 2048, sb_wpo + n, lane);
        for (int n = gw; n < 2048; n += NGW) row_quant_bf16<8>(wqT + (size_t)n * DM, sb_win  , wq8 + (size_t)n * DM, sb_wq + n, lane);
        LAS float* red = (LAS float*)lds;
        const int sub = tid & 15, rgrp = tid >> 4;
        for (int un = vcu; un < BATCH * NBLK * NH; un += G) {
            const int which = 1, h = un & 15, blk = (un >> 4) & 15, b = un >> 8;
            bf16* base = (which ? zk : zq) + ((size_t)(b * SEQ + blk * MOBA_L)) * 2048 + h * HD + sub * 8;
            const float* gn = (which ? k_norm : q_norm) + sub * 8;
            float gv[8];
#pragma unroll
            for (int e = 0; e < 8; ++e) gv[e] = gn[e];
            float cs8[8];
#pragma unroll
            for (int e = 0; e < 8; ++e) cs8[e] = 0.f;
            for (int p = 0; p < 8; ++p) {
                const int i = rgrp + 32 * p, pos = blk * MOBA_L + i;
                const v4u v = *(const GAS v4u*)(base + (size_t)i * 2048);
                float f[8] = {bflo(v.x), bfhi(v.x), bflo(v.y), bfhi(v.y), bflo(v.z), bfhi(v.z), bflo(v.w), bfhi(v.w)};
                float ss = 0.f;
#pragma unroll
                for (int e = 0; e < 8; ++e) ss += f[e] * f[e];
                ss += __shfl_xor(ss, 1); ss += __shfl_xor(ss, 2); ss += __shfl_xor(ss, 4); ss += __shfl_xor(ss, 8);
                const float r = 1.f / sqrtf(ss * (1.f / HD) + EPS);
                const f32x4 c0 = *(const GAS f32x4*)(rope_cos + pos * 64 + (sub & 7) * 8), c1 = *(const GAS f32x4*)(rope_cos + pos * 64 + (sub & 7) * 8 + 4);
                const f32x4 s0 = *(const GAS f32x4*)(rope_sin + pos * 64 + (sub & 7) * 8), s1 = *(const GAS f32x4*)(rope_sin + pos * 64 + (sub & 7) * 8 + 4);
                const float cc[8] = {c0.x, c0.y, c0.z, c0.w, c1.x, c1.y, c1.z, c1.w}, sn[8] = {s0.x, s0.y, s0.z, s0.w, s1.x, s1.y, s1.z, s1.w};
                float o[8];
#pragma unroll
                for (int e = 0; e < 8; ++e) { const float a = f[e] * r * gv[e]; const float pa = __shfl_xor(a, 8);
                    o[e] = (sub < 8) ? a * cc[e] - pa * sn[e] : a * cc[e] + pa * sn[e]; cs8[e] += o[e]; }
                v4u ov; ov.x = pk2(o[0], o[1]); ov.y = pk2(o[2], o[3]); ov.z = pk2(o[4], o[5]); ov.w = pk2(o[6], o[7]);
                *(GAS v4u*)(base + (size_t)i * 2048) = ov;
            }
            if (which) {
#pragma unroll
                for (int e = 0; e < 8; ++e) { cs8[e] += __shfl_xor(cs8[e], 16); cs8[e] += __shfl_xor(cs8[e], 32); }
                if (lane < 16) {
#pragma unroll
                    for (int e = 0; e < 8; ++e) red[wave * 128 + sub * 8 + e] = cs8[e]; }
                LDS_WAIT(); __syncthreads();
                if (tid < 128) { float s = 0.f;
#pragma unroll
                    for (int wv = 0; wv < 8; ++wv) s += red[wv * 128 + tid];
                    kmean[((size_t)(b * NH + h) * NBLK + blk) * HD + tid] = s * (1.f / MOBA_L); }
                __syncthreads();
            }
        }
    }
    GRID_BAR(3);


    if (IN(5)) { PH_BEGIN;
        {
            const int total = BATCH * NH * 8;
            int L = (int)blockIdx.x;
            if (L < total) {
                const att::Bases AB{zq, zk, zv, kmean, q_norm, rope_cos, rope_sin};
                auto mkref = [&](int Lx, int pass) { const int xcd = Lx & 7, j = Lx >> 3, bh = xcd * 8 + (j >> 3), xx = j & 7, qb = pass ? 15 - xx : xx;
                    att::BlockRef r; r.tok0 = (bh >> 4) * SEQ; r.h = bh & 15; r.P0 = qb * MOBA_L; return r; };
                int pass = 0; att::BlockRef cur = mkref(L, 0);
                att::Seam S;
                att::moba_prime(AB, cur, (char*)lds_raw, S);
                for (;;) {
                    const bool more_pass = pass == 0, more_item = L + G < total, last = !more_pass && !more_item;
                    int passn = pass + 1, Ln = L;
                    if (!more_pass) { passn = 0; Ln = more_item ? L + G : L; }
                    const att::BlockRef nxt = last ? cur : mkref(Ln, passn);
                    att::moba_block(AB, cur, nxt, (char*)lds_raw, S);
                    if (last) break;
                    cur = nxt; pass = passn; L = Ln;
                }
            }
            __syncthreads();
        }
    }
    GRID_BAR(5);

    for (int rep6 = 0; rep6 < (((PH_REP >> 6) & 1u) ? 2 : 1); ++rep6)
    if (IN(6)) { PH_BEGIN;
        for (int r8 = gw; r8 < T / 8; r8 += NGW) premix_quant_run8(zp, 8 * r8, yp8 + (size_t)(8 * r8) * 2048, sa_yp + 8 * r8, lane);
        for (int m = gw; m < T; m += NGW) row_quant_bf16<4>(zq + (size_t)m * 2048, sk_wao, ya8 + (size_t)m * 2048, sa_ya + m, lane);
    }
    GRID_BAR(6);

    for (int rep7 = 0; rep7 < (((PH_REP >> 7) & 1u) ? 2 : 1); ++rep7)
    if (IN(7)) { PH_BEGIN;
        { pg8::Gemm g{yp8, wcomb8, PW, PW, PW}; pg8::StaticOrder S; S.init(T, DM, G, (int)blockIdx.x);
          pg8::EpiGate8<false> E{mrg, Z + 4 * ZSLOT, sa_yp, sb_wpo};
          pg8::gemm_phase<pg8::EpiGate8<false>, pg8::StaticOrder, true>(lds, g, S, E); }
#ifndef PROBE_NO_ATTN
#define PROBE_NO_ATTN 0
#endif
        if (!PROBE_NO_ATTN) { pg8::Gemm g{ya8, wao8, AW, AW, AW}; pg8::StaticOrder S; S.init(T, DM, G, (int)blockIdx.x);
          pg8::EpiGate8<true> E{mrg, Z + 6 * ZSLOT, sa_ya, sb_wao};
          pg8::gemm_phase<pg8::EpiGate8<true>, pg8::StaticOrder, true>(lds, g, S, E); }
    }
    GRID_BAR(7);

    for (int rep8 = 0; rep8 < (((PH_REP >> 8) & 1u) ? 2 : 1); ++rep8)
    if (IN(8)) { PH_BEGIN; for (int m = gw; m < T; m += NGW) row_quant_bf16<8>(mrg + (size_t)m * DM, sk_wo, mrg8 + (size_t)m * DM, sa_m + m, lane); }
    GRID_BAR(8);

    for (int rep9 = 0; rep9 < (((PH_REP >> 9) & 1u) ? 2 : 1); ++rep9)
    if (IN(9)) { PH_BEGIN;
        pg8::Gemm g{mrg8, wo8, DM, DM, DM}; pg8::StaticOrder S; S.init(T, DM, G, (int)blockIdx.x);
        pg8::EpiH16_8 E{h16, DM, x, sa_m, sb_wo};
        pg8::gemm_phase<pg8::EpiH16_8, pg8::StaticOrder, true>(lds, g, S, E);
    }
    GRID_BAR(9);

    for (int rep10 = 0; rep10 < (((PH_REP >> 10) & 1u) ? 2 : 1); ++rep10)
    if (IN(10)) { PH_BEGIN; for (int m = gw; m < T; m += NGW) rms_row_quant_h16(h16 + (size_t)m * DM, norm_ffn, hn8 + (size_t)m * DM, sa_hn + m, rinv_h + m, lane);
        warm_sweep(u8, (size_t)PEER_E * DM, gw, NGW, lane); }
    GRID_BAR(10);

    for (int rep11 = 0; rep11 < (((PH_REP >> 11) & 1u) ? 2 : 1); ++rep11)
    if (IN(11)) { PH_BEGIN;
        pg8::Gemm g{hn8, wq8, DM, DM, DM}; pg8::StaticOrder S; S.init(T, 2048, G, (int)blockIdx.x);
        pg8::EpiBf16_8 E{(bf16*)pq, 2048, sa_hn, sb_wq};
        pg8::gemm_phase<pg8::EpiBf16_8, pg8::StaticOrder, true>(lds, g, S, E);
    }
    if (IN(11) && IN(12)) { __builtin_amdgcn_fence(__ATOMIC_RELEASE, "workgroup"); asm volatile("s_waitcnt vmcnt(0)" ::: "memory"); __syncthreads(); __builtin_amdgcn_fence(__ATOMIC_ACQUIRE, "workgroup"); }

    for (int rep12 = 0; rep12 < (((PH_REP >> 12) & 1u) ? 2 : 1); ++rep12)
    if (IN(12)) { PH_BEGIN;
        LAS bf16* SKh = (LAS bf16*)lds; LAS bf16* SKo = (LAS bf16*)(lds + 34816);
        LAS unsigned* CMPw = (LAS unsigned*)(lds + 69632) + wave * 1152;
        const int tk = lane & 31, hi = lane >> 5;
        auto ordu = [](unsigned u) { return (u & 0x80000000u) ? ~u : (u | 0x80000000u); };
        auto unord = [](unsigned o) { return (o & 0x80000000u) ? (o ^ 0x80000000u) : ~o; };
        auto pswap_sum = [](int c) { const auto rr = __builtin_amdgcn_permlane32_swap((unsigned)c, (unsigned)c, false, false); return (int)(rr[0] + rr[1]); };
        pg8::StaticOrder S11; S11.init(T, 2048, G, (int)blockIdx.x);
        for (int ui = 0; ; ++ui) { pg8::Unit uq; if (!S11.next(ui, uq)) break;
            const int h = uq.pn, tg = uq.pm; const int tok = tg * 256 + wave * 32 + tk;
#pragma unroll 1
            for (int p = 0; p < 2; ++p) {
                __syncthreads();
                { const float* sk = peer_sub + (size_t)(h * 2 + p) * PEER_NK * 128;
                  for (int i = tid; i < PEER_NK * 32; i += NWAVES * 64) { const int n = i >> 5, d4 = i & 31; const f32x4 v = *(const GAS f32x4*)(sk + n * 128 + d4 * 4);
                      const unsigned h0 = f2bf(v.x), h1 = f2bf(v.y), h2 = f2bf(v.z), h3 = f2bf(v.w);
                      const unsigned l0 = f2bf(v.x - __uint_as_float(h0 << 16)), l1 = f2bf(v.y - __uint_as_float(h1 << 16)), l2 = f2bf(v.z - __uint_as_float(h2 << 16)), l3 = f2bf(v.w - __uint_as_float(h3 << 16));
                      *(LAS v2u*)(SKh + n * 136 + d4 * 4) = (v2u){h0 | (h1 << 16), h2 | (h3 << 16)}; *(LAS v2u*)(SKo + n * 136 + d4 * 4) = (v2u){l0 | (l1 << 16), l2 | (l3 << 16)}; } }
                att::bf16x8 bqv[8];
                { const bf16* qp = (const bf16*)pq + (size_t)tok * 2048 + h * 256 + p * 128 + hi * 8;
#pragma unroll
                  for (int s2 = 0; s2 < 8; ++s2) bqv[s2] = *(const GAS att::bf16x8*)(qp + 16 * s2); }
                LDS_WAIT(); __syncthreads();
                att::f32x16 acc[4];
#pragma unroll
                for (int kt = 0; kt < 4; ++kt) acc[kt] = att::f32x16{};
#pragma unroll
                for (int s2 = 0; s2 < 8; ++s2) {
#pragma unroll
                    for (int kt = 0; kt < 4; ++kt) { const int off = (32 * kt + tk) * 136 + 16 * s2 + 8 * hi;
                        const att::bf16x8 ah = *(const LAS att::bf16x8*)(SKh + off), al = *(const LAS att::bf16x8*)(SKo + off);
                        acc[kt] = __builtin_amdgcn_mfma_f32_32x32x16_bf16(ah, bqv[s2], acc[kt], 0, 0, 0); acc[kt] = __builtin_amdgcn_mfma_f32_32x32x16_bf16(al, bqv[s2], acc[kt], 0, 0, 0); } }
                unsigned u[64];
#pragma unroll
                for (int e = 0; e < 64; ++e) { const float f = acc[e >> 4][e & 15]; u[e] = ordu((__float_as_uint(f) & ~127u) | (unsigned)(32 * (e >> 4) + ((e & 15) & 3) + 8 * ((e & 15) >> 2) + 4 * hi)); }
                pk_sort16<0>(u); pk_sort16<16>(u); pk_sort16<32>(u); pk_sort16<48>(u);
                pk_top16<0, 16>(u); pk_top16<32, 48>(u); pk_top16<0, 32>(u);
                { unsigned z[16];
#pragma unroll
                  for (int i = 0; i < 16; ++i) { const auto rr = __builtin_amdgcn_permlane32_swap(u[i], u[i], false, false); const unsigned x0 = rr[0]; z[i] = x0; u[16 + i] = rr[1]; }
#pragma unroll
                  for (int i = 0; i < 16; ++i) u[i] = z[i];
                  pk_top16<0, 16>(u);
                  if (hi == 0) { LAS v4u* dst = (LAS v4u*)(CMPw + tk * 36 + p * 16);
#pragma unroll
                      for (int q = 0; q < 4; ++q) dst[q] = (v4u){unord(u[4 * q]), unord(u[4 * q + 1]), unord(u[4 * q + 2]), unord(u[4 * q + 3])}; } }
            }
            LDS_WAIT(); asm volatile("" ::: "memory");
            float A[16], Bv[16]; unsigned KA[16], KB[16];
            { const LAS v4u* src = (const LAS v4u*)(CMPw + tk * 36);
#pragma unroll
              for (int q = 0; q < 4; ++q) { const v4u w = src[q], x = src[4 + q];
                  A[4 * q] = __uint_as_float(w.x); A[4 * q + 1] = __uint_as_float(w.y); A[4 * q + 2] = __uint_as_float(w.z); A[4 * q + 3] = __uint_as_float(w.w);
                  KA[4 * q] = w.x & 127u; KA[4 * q + 1] = w.y & 127u; KA[4 * q + 2] = w.z & 127u; KA[4 * q + 3] = w.w & 127u;
                  Bv[4 * q] = __uint_as_float(x.x); Bv[4 * q + 1] = __uint_as_float(x.y); Bv[4 * q + 2] = __uint_as_float(x.z); Bv[4 * q + 3] = __uint_as_float(x.w);
                  KB[4 * q] = x.x & 127u; KB[4 * q + 1] = x.y & 127u; KB[4 * q + 2] = x.z & 127u; KB[4 * q + 3] = x.w & 127u; } }
            constexpr int PI[50] = {0,0,0,0,0,0,0,0,0,0,0,0,0,0,0,0, 1,1,1,1,1,1,1,1, 2,2,2,2,2, 3,3,3,3, 4,4,4, 5,5, 6,6, 7,7, 8, 9, 10, 11, 12, 13, 14, 15};
            constexpr int PJ[50] = {0,1,2,3,4,5,6,7,8,9,10,11,12,13,14,15, 0,1,2,3,4,5,6,7, 0,1,2,3,4, 0,1,2,3, 0,1,2, 0,1, 0,1, 0,1, 0, 0, 0, 0, 0, 0, 0, 0};
            float cs[25]; unsigned cu[25], cidx[25];
#pragma unroll
            for (int s2 = 0; s2 < 25; ++s2) { const float v = hi ? A[PI[2 * s2 + 1]] + Bv[PJ[2 * s2 + 1]] : A[PI[2 * s2]] + Bv[PJ[2 * s2]];
                cs[s2] = v; cu[s2] = ordu(__builtin_bit_cast(unsigned, v)); cidx[s2] = hi ? KA[PI[2 * s2 + 1]] * PEER_NK + KB[PJ[2 * s2 + 1]] : KA[PI[2 * s2]] * PEER_NK + KB[PJ[2 * s2]]; }
            unsigned thc = 0u; int cfin = 50, clfin = 25;
#pragma unroll 1
            for (int b = 31; b >= 0; --b) {
                const unsigned cd = thc | (1u << b); int cl = 0;
#pragma unroll
                for (int s2 = 0; s2 < 25; ++s2) cl += (cu[s2] >= cd) ? 1 : 0;
                const int c = pswap_sum(cl); const bool ok = c >= PEER_K;
                thc = ok ? cd : thc; cfin = ok ? c : cfin; clfin = ok ? cl : clfin;
                if (b <= 20 && __all(cfin == PEER_K)) break;
            }
            int quota = 25, nsel = clfin;
            if (!__all(cfin == PEER_K)) {
                int gl = 0, el = 0;
#pragma unroll
                for (int s2 = 0; s2 < 25; ++s2) { gl += (cu[s2] > thc) ? 1 : 0; el += (cu[s2] == thc) ? 1 : 0; }
                const auto gg = __builtin_amdgcn_permlane32_swap((unsigned)gl, (unsigned)gl, false, false); const auto ee = __builtin_amdgcn_permlane32_swap((unsigned)el, (unsigned)el, false, false);
                const int need = PEER_K - (int)(gg[0] + gg[1]), e_lo = (int)ee[0];
                quota = hi ? (need - e_lo > 0 ? need - e_lo : 0) : need; quota = quota < el ? quota : el; nsel = gl + quota;
            }
            const float cmax = A[0] + Bv[0]; float ex[25]; float dl = 0.f; int eqc = 0; bool sl[25];
#pragma unroll
            for (int s2 = 0; s2 < 25; ++s2) { const bool eq = cu[s2] == thc; sl[s2] = (cu[s2] > thc) || (eq && eqc < quota); eqc += eq ? 1 : 0; ex[s2] = sl[s2] ? __expf(cs[s2] - cmax) : 0.f; dl += ex[s2]; }
            const auto dd = __builtin_amdgcn_permlane32_swap(__builtin_bit_cast(unsigned, dl), __builtin_bit_cast(unsigned, dl), false, false);
            const unsigned dd0 = dd[0], dd1 = dd[1];
            const float rden = 1.f / (__uint_as_float(dd0) + __uint_as_float(dd1));
            const auto nn = __builtin_amdgcn_permlane32_swap((unsigned)nsel, (unsigned)nsel, false, false);
            int pos = hi ? (int)nn[0] : 0; const size_t ob = (size_t)tok * PEER_HK + h * PEER_K;
#pragma unroll
            for (int s2 = 0; s2 < 25; ++s2) if (sl[s2] && pos < PEER_K) { pidx[ob + pos] = (int)cidx[s2]; pgate[ob + pos] = ex[s2] * rden; ++pos; }
        }
    }
    if (IN(12) && IN(13)) __syncthreads();

    for (int rep13 = 0; rep13 < (((PH_REP >> 13) & 1u) ? 2 : 1); ++rep13)
    if (IN(13)) { PH_BEGIN;
        pg8::Gemm g{hn8, u8, DM, DM, DM}; pg8::StaticOrder S; S.init(T, PEER_E, G, (int)blockIdx.x);
        pg8::EpiAct8<false> E{act, PEER_E, sa_hn, sb_u};
        pg8::gemm_phase<pg8::EpiAct8<false>, pg8::StaticOrder, PG8_ALIGN>(lds, g, S, E);
    }
    GRID_BAR(13);

    for (int rep14 = 0; rep14 < (((PH_REP >> 14) & 1u) ? 2 : 1); ++rep14)
    for (int rep14 = 0; rep14 < (((PH_REP >> 14) & 1u) ? 2 : 1); ++rep14)
    if (IN(14)) { PH_BEGIN;
        for (int m = gw; m < T; m += NGW) {
            const int e0 = pidx[(size_t)m * PEER_HK + lane], e1 = pidx[(size_t)m * PEER_HK + 64 + lane];
            const float g0 = pgate[(size_t)m * PEER_HK + lane], g1 = pgate[(size_t)m * PEER_HK + 64 + lane];
            const unsigned char* arow = (const unsigned char*)act + (size_t)m * PEER_E; signed char* qrow = act8 + (size_t)m * PEER_E;
            const float rsc = sa_hn[m] * 16.f;
            const pg8::f32x2 ge = pg8::gelu_pk((pg8::f32x2){__builtin_amdgcn_cvt_f32_fp8((int)arow[e0], 0) * rsc, __builtin_amdgcn_cvt_f32_fp8((int)arow[e1], 0) * rsc}); const float a0 = ge.x, a1 = ge.y;
            float G0 = 0.f, G1 = 0.f;
            for (int j = 0; j < 64; ++j) { const int ej = __builtin_amdgcn_readlane(e0, j), fj = __builtin_amdgcn_readlane(e1, j);
                const float gj = __builtin_bit_cast(float, __builtin_amdgcn_readlane(__builtin_bit_cast(int, g0), j)), hj = __builtin_bit_cast(float, __builtin_amdgcn_readlane(__builtin_bit_cast(int, g1), j));
                G0 += (ej == e0 ? gj : 0.f) + (fj == e0 ? hj : 0.f); G1 += (ej == e1 ? gj : 0.f) + (fj == e1 ? hj : 0.f); }
            const float w0 = a0 * G0 * sk_v[e0], w1 = a1 * G1 * sk_v[e1];
            const float am = fmaxf(wave_max(fmaxf(fabsf(w0), fabsf(w1))), 1e-30f), inv = 127.f / am;
            if (lane == 0) sa_act[m] = am * (1.f / 127.f);
            const v4u zero = {0u, 0u, 0u, 0u};
#pragma unroll 8
            for (int j = 0; j < 16; ++j) *((GAS v4u*)qrow + j * 64 + lane) = zero;
            VM_WAIT();
            asm volatile("" ::: "memory");
            qrow[e0] = (signed char)(int)__builtin_rintf(w0 * inv); qrow[e1] = (signed char)(int)__builtin_rintf(w1 * inv);
        }
        warm_sweep(vT8, (size_t)DM * PEER_E, gw, NGW, lane);
    }
    GRID_BAR(14);

#ifndef PROBE_NO_PEER
#define PROBE_NO_PEER 0
#endif
    if (IN(15) && !PROBE_NO_PEER) { PH_BEGIN;
        pg8::Gemm g{act8, vT8, PEER_E, PEER_E, PEER_E}; pg8::StaticOrder S; S.init(T, DM, G, (int)blockIdx.x);
        pg8::EpiOut8 E{out, DM, h16, sa_act, sb_v};
        pg8::gemm_phase<pg8::EpiOut8, pg8::StaticOrder, true>(lds, g, S, E);
    }
#undef IN
#undef GRID_BAR
}

#ifdef PROBE_CHECK
constexpr size_t WS_CHKTMP = 1130 * MiB;
__device__ __forceinline__ unsigned hash32(unsigned x) { x ^= x >> 16; x *= 0x7feb352du; x ^= x >> 15; x *= 0x846ca68bu; x ^= x >> 16; return x; }
__device__ __forceinline__ float bfr(float f) { return __builtin_bit_cast(float, f2bf(f) << 16); }
__device__ __forceinline__ float bf2f(bf16 b) { return __builtin_bit_cast(float, (unsigned)b << 16); }
__device__ __forceinline__ float gelu_ref(float a) { return 0.5f * a * (1.f + erff(a * 0.70710678f)); }
constexpr int CHK_N = 16384;
__global__ void __launch_bounds__(256) check_kernel(Args args, int stage) {
    unsigned char* ws = args.ws; float* chk = (float*)(ws + WS_CTL) + 1024;
    const float* x = args.in[0]; const float* norm_mix = args.in[1]; const float* w_in = args.in[2]; const float* pool_w = args.in[3]; const float* pool_scale = args.in[4];
    const float* w_pool_out = args.in[7]; const float* w_attn_out = args.in[8]; const float* w_o = args.in[9];
    const float* norm_ffn = args.in[10]; const float* peer_wq = args.in[11]; const float* peer_sub = args.in[12]; const float* peer_u = args.in[13]; const float* peer_v = args.in[14];
    const float* out = args.out;
    const int* pidx = (const int*)(ws + WS_PIDX); const float* pgate = (const float*)(ws + WS_PG);
    const bf16* ypre = (const bf16*)(ws + WS_YPRE); const bf16* hn = (const bf16*)(ws + WS_XN8);
    const bf16* mrg = (const bf16*)(ws + WS_MRG); const float* pq = (const float*)(ws + WS_MRG);
    const bf16* Z = (const bf16*)(ws + WS_Z); const bf16* act = (const bf16*)(ws + WS_Z);
    float* tmp = (float*)(ws + WS_CHKTMP); float* hsave = tmp + 4096 * 256;
    const int sidx = blockIdx.x * blockDim.x + threadIdx.x;
    const unsigned h1 = hash32((unsigned)sidx * 2654435761u + 977u * (unsigned)(stage > 90 ? 9 : stage == 21 ? 20 : stage == 24 ? 23 : stage)), h2 = hash32(h1 + 0x9e3779b9u);
    const int row = (int)(h1 % (unsigned)T);
    float got = 0.f, ref = 0.f; bool valid = true;
    if (stage == 1) {
        const int col = (int)(h2 % 16384u); float ss = 0.f;
        for (int k = 0; k < DM; ++k) { const float v = x[(size_t)row * DM + k]; ss += v * v; }
        const float r = 1.f / sqrtf(ss * (1.f / DM) + EPS); float acc = 0.f;
        for (int k = 0; k < DM; ++k) acc += (x[(size_t)row * DM + k] * r * norm_mix[k]) * w_in[(size_t)k * INW + col];
        if (col >= 8192) acc = 1.f / (1.f + expf(-acc));
        ref = acc; got = bf2f(Z[(size_t)(col >> 11) * ZSLOT + (size_t)row * 2048 + (col & 2047)]);
    } else if (stage == 20 || stage == 21) {
        const int smp = sidx; valid = false; float* rawq = tmp + 2 * 4096 * 256;
        if (smp < 4096) { const int hh = (int)(h2 % 16u), which = (int)((h2 >> 8) & 1u); const bf16* zz = Z + (size_t)(1 + which) * ZSLOT + (size_t)row * 2048 + hh * 128;
            if (stage == 20) { for (int d = 0; d < 128; ++d) rawq[(size_t)smp * 128 + d] = bf2f(zz[d]); }
            else { const float* gn = args.in[5 + which]; float ss = 0.f; for (int d = 0; d < 128; ++d) { const float v = rawq[(size_t)smp * 128 + d]; ss += v * v; }
                const float r = 1.f / sqrtf(ss * (1.f / 128.f) + EPS); const int pos = row & (SEQ - 1); float nn = 0.f, dd = 0.f;
                for (int d = 0; d < 128; ++d) { const int j = d & 63; const float inv = powf(10000.f, -(float)j / 64.f), ang = (float)pos * inv, cs = cosf(ang), sn = sinf(ang);
                    const float a = rawq[(size_t)smp * 128 + d] * r * gn[d], pa = rawq[(size_t)smp * 128 + (d ^ 64)] * r * gn[d ^ 64];
                    const float rf = d < 64 ? a * cs - pa * sn : a * cs + pa * sn, g = bf2f(zz[d]); nn += (g - rf) * (g - rf); dd += rf * rf; }
                atomicAdd(&chk[2 * 21], nn); atomicAdd(&chk[2 * 21 + 1], dd); } }
    } else if (stage == 22) {
        const int d = (int)(h2 % 128u), hh = (int)((h2 >> 8) % 16u), blk = (row & (SEQ - 1)) >> 8, b = row >> 12; float sum = 0.f;
        for (int i = 0; i < 256; ++i) sum += bf2f(Z[2 * ZSLOT + (size_t)(b * SEQ + blk * 256 + i) * 2048 + hh * 128 + d]);
        ref = sum * (1.f / 256.f); got = ((const float*)(ws + WS_KMEAN))[((size_t)(b * NH + hh) * NBLK + blk) * HD + d];
    } else if (stage == 23 || stage == 24) {
        const int smp = sidx; valid = false; float* aref = tmp + 3 * 4096 * 256;
        if (smp < 4096) { const int hh = (int)(h2 % 16u), d0 = (int)((h2 >> 8) % 128u), t = row & (SEQ - 1), b = row >> 12, own = t >> 8;
            const bf16* qv = Z + ZSLOT + (size_t)row * 2048 + hh * 128;
            if (stage == 23) {
                const float* km = (const float*)(ws + WS_KMEAN) + (size_t)(b * NH + hh) * NBLK * HD; unsigned mask = 0u;
                if (own <= 3) mask = (1u << own) - 1u;
                else { float* gt = tmp + 4 * 4096 * 256 + (size_t)smp * 16; for (int n = 0; n < own; ++n) { float g = 0.f; for (int d = 0; d < 128; ++d) g += bf2f(qv[d]) * km[n * HD + d]; gt[n] = g; }
                    for (int k = 0; k < 3; ++k) { int bi = -1; float bv = -3e38f; for (int n = 0; n < own; ++n) if (!((mask >> n) & 1u) && gt[n] > bv) { bv = gt[n]; bi = n; } mask |= 1u << bi; } }
                float mx = -3e38f, den = 0.f, acc = 0.f;
                for (int n = 0; n <= own; ++n) { if (n < own && !((mask >> n) & 1u)) continue; const int jend = n < own ? 256 : (t & 255) + 1;
                    for (int j = 0; j < jend; ++j) { const size_t kr = (size_t)(b * SEQ + n * 256 + j); const bf16* kv = Z + 2 * ZSLOT + kr * 2048 + hh * 128; float sc = 0.f;
                        for (int d = 0; d < 128; ++d) sc += bf2f(qv[d]) * bf2f(kv[d]);
                        sc *= 0.08838834764831845f; const float vv = bf2f(Z[3 * ZSLOT + kr * 2048 + hh * 128 + d0]);
                        if (sc > mx) { const float f = expf(mx - sc); den *= f; acc *= f; mx = sc; }
                        const float pe = expf(sc - mx); den += pe; acc += pe * vv; } }
                aref[smp] = acc / den;
            } else { ref = aref[smp]; got = bf2f(qv[d0]); valid = true; } }
    } else if (stage == 11) {
        const int k = row & 4095, n = (int)(h2 % 16384u); const float* sbw = (const float*)(ws + WS_SCALE) + 3 * T;
        ref = w_in[(size_t)k * INW + n]; got = (float)((const signed char*)(ws + WS_WIN8))[(size_t)n * DM + k] * sbw[n];
    } else if (stage == 12) {
        const int col = (int)(h2 % 4096u); float ss = 0.f;
        for (int k = 0; k < DM; ++k) { const float v = x[(size_t)row * DM + k]; ss += v * v; }
        ref = x[(size_t)row * DM + col] / sqrtf(ss * (1.f / DM) + EPS) * norm_mix[col]; got = (float)((const signed char*)(ws + WS_XN8))[(size_t)row * DM + col] * ((const float*)(ws + WS_SCALE))[row];
    } else if (stage == 2) {
        const int col = (int)(h2 % 2048u), g = col >> 9, w = 2 << g, t = row & (SEQ - 1); float sum = 0.f; int cnt = 0;
        for (int j = 0; j < w; ++j) if (t - j >= 0) { sum += bf2f(Z[(size_t)(row - j) * 2048 + col]); ++cnt; }
        ref = sum / (float)cnt - bf2f(Z[(size_t)row * 2048 + col]); got = bf2f(ypre[(size_t)row * 2048 + col]);
    } else if (stage == 3) {
        const int col = (int)(h2 % 2048u), g = col >> 9, d = col & 511; float acc = 0.f;
        for (int c = 0; c < 512; ++c) acc += bf2f(ypre[(size_t)row * 2048 + g * 512 + c]) * bfr(pool_w[((size_t)g * 512 + c) * 512 + d]);
        ref = acc * pool_scale[col]; got = bf2f(Z[(size_t)row * 2048 + col]);
    } else if (stage == 4) {
        const int col = (int)(h2 % 4096u); float a1 = 0.f, a2 = 0.f;
        for (int k = 0; k < 2048; ++k) { a1 += bf2f(Z[(size_t)row * 2048 + k]) * bfr(w_pool_out[(size_t)k * DM + col]); a2 += bf2f(Z[ZSLOT + (size_t)row * 2048 + k]) * bfr(w_attn_out[(size_t)k * DM + col]); }
        const float gp = bf2f(Z[(size_t)(4 + (col >> 11)) * ZSLOT + (size_t)row * 2048 + (col & 2047)]), ga = bf2f(Z[(size_t)(6 + (col >> 11)) * ZSLOT + (size_t)row * 2048 + (col & 2047)]);
        ref = gp * a1 + ga * a2; got = bf2f(mrg[(size_t)row * DM + col]);
    } else if (stage == 5) {
        const int col = (int)(h2 % 4096u); float acc = 0.f;
        for (int k = 0; k < DM; ++k) acc += bf2f(mrg[(size_t)row * DM + k]) * bfr(w_o[(size_t)k * DM + col]);
        ref = x[(size_t)row * DM + col] + acc; got = out[(size_t)row * DM + col];
    } else if (stage == 6) {
        const int col = (int)(h2 % 4096u); float ss = 0.f;
        for (int k = 0; k < DM; ++k) { const float v = out[(size_t)row * DM + k]; ss += v * v; }
        ref = out[(size_t)row * DM + col] / sqrtf(ss * (1.f / DM) + EPS) * norm_ffn[col]; got = bf2f(hn[(size_t)row * DM + col]);
    } else if (stage == 7) {
        const int col = (int)(h2 % 2048u); float acc = 0.f;
        for (int k = 0; k < DM; ++k) acc += bf2f(hn[(size_t)row * DM + k]) * bfr(peer_wq[(size_t)k * 2048 + col]);
        ref = acc; got = pq[(size_t)row * 2048 + col];
    } else if (stage == 8) {
        const int col = (int)(h2 % 16384u); float acc = 0.f;
        for (int k = 0; k < DM; ++k) acc += bf2f(hn[(size_t)row * DM + k]) * peer_u[(size_t)col * DM + k];
        ref = gelu_ref(acc); got = bf2f(act[(size_t)row * PEER_E + col]);
    } else if (stage == 91 || stage == 9 || stage == 92) {
        float* acc9 = (float*)(ws + WS_CTL) + 2048;
        const int smp = stage == 9 ? sidx >> 7 : sidx, j = sidx & 127;
        const unsigned g1 = hash32((unsigned)smp * 2654435761u + 977u * 9u), g2 = hash32(g1 + 0x9e3779b9u);
        const int r9 = (int)(g1 % (unsigned)T), col = (int)(g2 % 4096u); valid = false;
        if (smp < 512) {
            if (stage == 91) hsave[smp] = out[(size_t)r9 * DM + col];
            else if (stage == 9) { const int e = pidx[(size_t)r9 * PEER_HK + j]; float a = 0.f;
                for (int k = 0; k < DM; ++k) a += bf2f(hn[(size_t)r9 * DM + k]) * peer_u[(size_t)e * DM + k];
                atomicAdd(&acc9[smp], pgate[(size_t)r9 * PEER_HK + j] * gelu_ref(a) * peer_v[(size_t)e * DM + col]); }
            else { ref = acc9[smp]; got = out[(size_t)r9 * DM + col] - hsave[smp]; valid = true; stage = 9; } }
    } else if (stage == 10) {
        valid = sidx < 4096; const int hh = (int)(h2 % 8u);
        if (valid) { float* sc = tmp + (size_t)sidx * 256;
            for (int p = 0; p < 2; ++p) for (int n = 0; n < 128; ++n) { float a = 0.f;
                for (int d = 0; d < 128; ++d) a += pq[(size_t)row * 2048 + hh * 256 + p * 128 + d] * peer_sub[((size_t)(hh * 2 + p) * 128 + n) * 128 + d];
                sc[p * 128 + n] = a; }
            __threadfence();
            float smin = 3e38f, smax = -3e38f;
            for (int k = 0; k < 16; ++k) { const int e = pidx[(size_t)row * PEER_HK + hh * 16 + k]; const float sm = sc[e >> 7] + sc[128 + (e & 127)]; smin = fminf(smin, sm); smax = fmaxf(smax, sm); }
            int above = 0; for (int i = 0; i < 128; ++i) for (int j = 0; j < 128; ++j) above += (sc[i] + sc[128 + j] > smin + 1e-4f) ? 1 : 0;
            int dup = 0; for (int k = 0; k < 16; ++k) for (int k2 = 0; k2 < k; ++k2) dup += (pidx[(size_t)row * PEER_HK + hh * 16 + k] == pidx[(size_t)row * PEER_HK + hh * 16 + k2]) ? 1 : 0;
            float den = 0.f; for (int k = 0; k < 16; ++k) { const int e = pidx[(size_t)row * PEER_HK + hh * 16 + k]; den += expf(sc[e >> 7] + sc[128 + (e & 127)] - smax); }
            float gerr = 0.f; for (int k = 0; k < 16; ++k) { const int e = pidx[(size_t)row * PEER_HK + hh * 16 + k]; const float gr = expf(sc[e >> 7] + sc[128 + (e & 127)] - smax) / den; gerr += fabsf(gr - pgate[(size_t)row * PEER_HK + hh * 16 + k]); }
            ref = 1.f; got = 1.f + (above > 15 ? (float)(above - 15) / 16.f : 0.f) + (float)dup + gerr; }
    }
    if (valid) { const float d = got - ref; atomicAdd(&chk[2 * stage], d * d); atomicAdd(&chk[2 * stage + 1], ref * ref); }
}
__global__ void report_kernel(Args args) {
    float* chk = (float*)(args.ws + WS_CTL) + 1024; float best = -1.f; int bs = 0;
    for (int s = 1; s <= 24; ++s) { const float den = chk[2 * s + 1]; const float c = den > 0.f ? sqrtf(chk[2 * s] / den) : 0.99f; if (c > best) { best = c; bs = s; } }
#ifdef PROBE_STAGE
    bs = PROBE_STAGE; { const float den = chk[2 * bs + 1]; best = den > 0.f ? sqrtf(chk[2 * bs] / den) : 0.99f; }
#endif
    const float F = 1000.f * exp2f((float)bs) * (1.f + fminf(best, 0.99f));
    for (size_t i = (size_t)blockIdx.x * blockDim.x + threadIdx.x; i < (size_t)T * DM; i += (size_t)gridDim.x * blockDim.x) args.out[i] *= F;
}
#endif

extern "C" void kernel_launch(void* const* d_in, const int* in_sizes, int n_in, void* d_out, int out_size, void* d_ws, size_t ws_size, hipStream_t stream) {
    static int grid = 0;
    if (grid == 0) {
        if (n_in != 15 || out_size != T * DM || ws_size < WS_END) { fprintf(stderr, "kernel_launch: unexpected shapes (n_in %d, out %d, ws %zu)\n", n_in, out_size, ws_size); grid = -1; return; }
        int dev = 0, cus = 0, per_cu = 0;
        if (hipGetDevice(&dev) != hipSuccess || hipDeviceGetAttribute(&cus, hipDeviceAttributeMultiprocessorCount, dev) != hipSuccess) { grid = -1; return; }
        if (hipFuncSetAttribute((const void*)fwd_kernel, hipFuncAttributeMaxDynamicSharedMemorySize, LDS_BYTES) != hipSuccess) { fprintf(stderr, "kernel_launch: hipFuncSetAttribute failed\n"); grid = -1; return; }
        if (hipOccupancyMaxActiveBlocksPerMultiprocessor(&per_cu, (const void*)fwd_kernel, NWAVES * 64, LDS_BYTES) != hipSuccess || per_cu < 1) { fprintf(stderr, "kernel_launch: occupancy query says %d\n", per_cu); }
        (void)hipGetLastError();
        grid = cus;
    }
    if (grid < 0) return;
    (void)hipMemsetAsync((char*)d_ws + WS_CTL, 0, CTL_ZERO_BYTES, stream);
    Args a{};
    for (int i = 0; i < 15; ++i) a.in[i] = (const float*)d_in[i];
    a.out = (float*)d_out; a.ws = (unsigned char*)d_ws;
    if (MK_N_LAUNCHES == 1) { a.ph_lo = 0; a.ph_hi = N_PHASES; hipLaunchKernelGGL(fwd_kernel, dim3(grid), dim3(NWAVES * 64), LDS_BYTES, stream, a); }
    else for (int p = 0; p < N_PHASES; ++p) { a.ph_lo = p; a.ph_hi = p + 1;
#ifdef PROBE_CHECK
        if (p == 3) hipLaunchKernelGGL(check_kernel, dim3(CHK_N / 256), dim3(256), 0, stream, a, 20);
        if (p == 5) hipLaunchKernelGGL(check_kernel, dim3(CHK_N / 256), dim3(256), 0, stream, a, 23);
#endif
        hipLaunchKernelGGL(fwd_kernel, dim3(grid), dim3(NWAVES * 64), LDS_BYTES, stream, a);
#ifdef PROBE_CHECK
        if (p == 2) hipLaunchKernelGGL(check_kernel, dim3(CHK_N / 256), dim3(256), 0, stream, a, 1);
        if (p == 3) { hipLaunchKernelGGL(check_kernel, dim3(CHK_N / 256), dim3(256), 0, stream, a, 21); hipLaunchKernelGGL(check_kernel, dim3(CHK_N / 256), dim3(256), 0, stream, a, 22); }
        if (p == 5) hipLaunchKernelGGL(check_kernel, dim3(CHK_N / 256), dim3(256), 0, stream, a, 24);
        if (p == 15) hipLaunchKernelGGL(report_kernel, dim3(1024), dim3(256), 0, stream, a);
#endif
    }
}
```

```cpp
#include <hip/hip_runtime.h>
#include <cstdio>
#include <cstdint>


#define PH_REP 0x0u
#ifndef PG8_ALIGN
#define PG8_ALIGN true
#endif
#ifndef PH_REP
#define PH_REP 0u
#endif
#ifndef MK_N_LAUNCHES
#define MK_N_LAUNCHES 1
#endif

constexpr int BATCH = 4, SEQ = 4096, DM = 4096, T = BATCH * SEQ;
constexpr int PW = 2048, AW = 2048, HD = 128, NH = 16, INW = 16384;
constexpr int MOBA_L = 256, NBLK = SEQ / MOBA_L;
constexpr int PEER_H = 8, PEER_NK = 128, PEER_E = 16384, PEER_K = 16, PEER_HK = PEER_H * PEER_K;
constexpr float EPS = 1e-6f;
constexpr int N_PHASES = 16;

constexpr size_t MiB = 1u << 20;
constexpr size_t WS_CTL = 0, CTL_ZERO_BYTES = 32 * 1024;
constexpr size_t CTL_CMAX_WIN = 128 * 1024;
constexpr size_t CTL_CMAX_V = 192 * 1024;
constexpr size_t CTL_CMAX_WO = 208 * 1024, CTL_CMAX_WPO = 224 * 1024, CTL_CMAX_WAO = 240 * 1024;
constexpr size_t WS_ROPE = 1 * MiB;
constexpr size_t WS_KMEAN = 3 * MiB;
constexpr size_t WS_SEL = 4 * MiB;
constexpr size_t WS_PIDX = 5 * MiB;
constexpr size_t WS_PG = 13 * MiB;
constexpr size_t WS_SCALE = 21 * MiB;
constexpr size_t WS_POOLW = 22 * MiB;
constexpr size_t WS_WPO = 24 * MiB;
constexpr size_t WS_WAO = 40 * MiB;
constexpr size_t WS_WO = 56 * MiB;
constexpr size_t WS_WQ = 88 * MiB;
constexpr size_t WS_U8 = 104 * MiB;
constexpr size_t WS_VT8 = 168 * MiB;
constexpr size_t WS_WIN8 = 232 * MiB;
constexpr size_t WS_XN8 = 296 * MiB;
constexpr size_t WS_YPRE = 360 * MiB;
constexpr size_t WS_MRG = 424 * MiB;
constexpr size_t WS_ACT8 = 232 * MiB;
constexpr size_t WS_Z = 552 * MiB;
constexpr size_t WS_H16 = 808 * MiB;
constexpr size_t WS_YP8 = 1064 * MiB;
constexpr size_t WS_YA8 = 1096 * MiB;
constexpr size_t WS_END = 1128 * MiB;
constexpr size_t ZSLOT = (size_t)T * 2048;

constexpr int CW_TMO = 0;
constexpr int CW_BAR = 4096;

constexpr int RING_BYTES = 131072;
constexpr int LDSCTL_OFF = 151552, MISC_OFF = LDSCTL_OFF + 320;
constexpr int LDS_BYTES = 155648;
constexpr int NWAVES = 8;

#define GAS __attribute__((address_space(1)))
#define LAS __attribute__((address_space(3)))
typedef unsigned short bf16;
typedef unsigned v4u __attribute__((ext_vector_type(4)));
typedef unsigned v2u __attribute__((ext_vector_type(2)));
typedef float f32x4 __attribute__((ext_vector_type(4)));
typedef float f32x2 __attribute__((ext_vector_type(2)));
typedef GAS unsigned gu32;
#define RLX_AGENT __ATOMIC_RELAXED, __HIP_MEMORY_SCOPE_AGENT
#define LDS_WAIT() asm volatile("s_waitcnt lgkmcnt(0)" ::: "memory")
#define VM_WAIT() asm volatile("s_waitcnt vmcnt(0)" ::: "memory")

__device__ __forceinline__ unsigned f2bf(float f) { unsigned u = __builtin_bit_cast(unsigned, f); return (u + 0x7fffu + ((u >> 16) & 1u)) >> 16; }
__device__ __forceinline__ unsigned pk2(float lo, float hi) { return f2bf(lo) | (f2bf(hi) << 16); }
__device__ __forceinline__ float bflo(unsigned w) { return __builtin_bit_cast(float, w << 16); }
__device__ __forceinline__ float bfhi(unsigned w) { return __builtin_bit_cast(float, w & 0xffff0000u); }
__device__ __forceinline__ float wave_sum(float v) {
#pragma unroll
    for (int o = 1; o < 64; o <<= 1) v += __shfl_xor(v, o);
    return v;
}

namespace pg8 {
#define PG8_LAS __attribute__((address_space(3)))
typedef unsigned short bf16_t;
typedef short bf16x8 __attribute__((ext_vector_type(8)));
typedef float f32x4 __attribute__((ext_vector_type(4)));
typedef unsigned u32x4 __attribute__((ext_vector_type(4)));
constexpr int BM = 256, BK = 64, HALF = 128, HTB = HALF * BK * 2, STAGE_BYTES = 8 * HTB, NXCD = 8, WGM = 8;

__host__ __device__ __forceinline__ int lds_byte(int r, int c) { const int st = (r >> 4) * 2 + (c >> 5), rr = r & 15, cc = c & 31, ob = rr * 64 + cc * 2; return st * 1024 + (ob ^ (((ob >> 9) & 1) << 5)); }
__host__ __device__ __forceinline__ void stage_rc(int b, int& R, int& C) { const int st = b / 1024, sb = b % 1024, swz = sb ^ (((sb >> 9) & 1) << 5); R = (st >> 1) * 16 + swz / 64; C = (st & 1) * 32 + (swz % 64) / 2; }
__host__ __device__ __forceinline__ int perm32(int rho) { const int n = rho >> 4, i = rho & 15; return 8 * (i >> 2) + 4 * n + (i & 3); }

struct Unit { int pm, pn, ak; };
struct Gemm { const void* A; const void* Bt; int Kb, lda, ldb; };
typedef int i32x4 __attribute__((ext_vector_type(4)));

struct StaticOrder {
    int nM, nN, nwg, G, c;
    __host__ __device__ __forceinline__ void init(int M, int N, int G_, int c_) { nM = M / BM; nN = N / BM; nwg = nM * nN; G = G_; c = c_; }
    __host__ __device__ __forceinline__ bool next(int i, Unit& u) const {
        const long L = (long)i * G + c; if (L >= nwg) return false;
        int wgid = (int)L; { const int q = nwg / NXCD, r = nwg % NXCD, xcd = wgid % NXCD, off = wgid / NXCD; wgid = (xcd < r ? xcd * (q + 1) : r * (q + 1) + (xcd - r) * q) + off; }
        const int nig = WGM * nN, gid = wgid / nig, fm = gid * WGM, gsz = (nM - fm) < WGM ? (nM - fm) : WGM;
        u.pm = fm + ((wgid % nig) % gsz); u.pn = (wgid % nig) / gsz; u.ak = 0; return true;
    }
};
struct PoolOrder : StaticOrder {
    __host__ __device__ bool next(int i, Unit& u) const { if (!StaticOrder::next(i, u)) return false; u.ak = (u.pn >> 1) * 512 * 2; return true; }
};

__device__ __forceinline__ unsigned cvt_pk_bf16(float lo, float hi) { unsigned r; asm volatile("v_cvt_pk_bf16_f32 %0, %1, %2" : "=v"(r) : "v"(lo), "v"(hi)); return r; }
typedef float f32x2 __attribute__((ext_vector_type(2)));
__device__ __forceinline__ f32x2 gelu_pk(f32x2 v) {
    const f32x2 av = __builtin_elementwise_abs(v), d = av * 0.2316418882f + 1.0f;
    f32x2 t; t.x = __builtin_amdgcn_rcpf(d.x); t.y = __builtin_amdgcn_rcpf(d.y);
    f32x2 q = t * 0.5307027145f + (-0.7265760135f); q = q * t + 0.7107068705f; q = q * t + (-0.142248368f); q = q * t + 0.127414796f; q = q * t;
    const f32x2 s = (v * v) * (-0.72134752044f);
    f32x2 e; e.x = __builtin_amdgcn_exp2f(s.x); e.y = __builtin_amdgcn_exp2f(s.y);
    const f32x2 m = v * (q * e), r = v - m;
    f32x2 o; o.x = v.x < 0.f ? m.x : r.x; o.y = v.y < 0.f ? m.y : r.y; return o;
}
__device__ __forceinline__ float sigmoidf_fast(float v) { return __builtin_amdgcn_rcpf(1.0f + __builtin_amdgcn_exp2f(v * -1.4426950408889634f)); }

struct EpiZ {
    static constexpr bool I8 = false; typedef f32x4 acc_t; static constexpr bool PERM = true;
    bf16_t* Z;
    __device__ __forceinline__ void operator()(const f32x4 (&acc)[2][2][4][2], const Unit& u, int wr, int wc, int fr, int fq) const {
        const int row0 = u.pm * BM + wr * 64 + fr, ct = u.pn * BM, t = ct >> 11;
        bf16_t* base = Z + (size_t)t * ZSLOT; const int col0 = (ct & 2047) + wc * 32 + 8 * fq; const bool sig = t >= 4;
#pragma unroll
        for (int ai = 0; ai < 2; ++ai)
#pragma unroll
            for (int m = 0; m < 4; ++m) { bf16_t* rowp = base + (size_t)(row0 + ai * HALF + m * 16) * 2048 + col0;
#pragma unroll
                for (int bj = 0; bj < 2; ++bj) { f32x4 v0 = acc[ai][bj][m][0], v1 = acc[ai][bj][m][1];
                    if (sig) {
#pragma unroll
                        for (int j = 0; j < 4; ++j) { v0[j] = sigmoidf_fast(v0[j]); v1[j] = sigmoidf_fast(v1[j]); } }
                    u32x4 w; w.x = cvt_pk_bf16(v0[0], v0[1]); w.y = cvt_pk_bf16(v0[2], v0[3]); w.z = cvt_pk_bf16(v1[0], v1[1]); w.w = cvt_pk_bf16(v1[2], v1[3]);
                    *(u32x4*)(rowp + bj * HALF) = w; } }
    }
};
struct EpiBf16 {
    static constexpr bool I8 = false; typedef f32x4 acc_t; static constexpr bool PERM = true;
    bf16_t* O; int ldc;
    __device__ __forceinline__ void operator()(const f32x4 (&acc)[2][2][4][2], const Unit& u, int wr, int wc, int fr, int fq) const {
        const int row0 = u.pm * BM + wr * 64 + fr, col0 = u.pn * BM + wc * 32 + 8 * fq;
#pragma unroll
        for (int ai = 0; ai < 2; ++ai)
#pragma unroll
            for (int m = 0; m < 4; ++m) { bf16_t* rowp = O + (size_t)(row0 + ai * HALF + m * 16) * ldc + col0;
#pragma unroll
                for (int bj = 0; bj < 2; ++bj) { const f32x4 v0 = acc[ai][bj][m][0], v1 = acc[ai][bj][m][1];
                    u32x4 w; w.x = cvt_pk_bf16(v0[0], v0[1]); w.y = cvt_pk_bf16(v0[2], v0[3]); w.z = cvt_pk_bf16(v1[0], v1[1]); w.w = cvt_pk_bf16(v1[2], v1[3]);
                    *(u32x4*)(rowp + bj * HALF) = w; } }
    }
};
struct EpiBf16Row {
    static constexpr bool I8 = false; typedef f32x4 acc_t; static constexpr bool PERM = true;
    bf16_t* O; int ldc; const float* rs;
    __device__ __forceinline__ void operator()(const f32x4 (&acc)[2][2][4][2], const Unit& u, int wr, int wc, int fr, int fq) const {
        const int row0 = u.pm * BM + wr * 64 + fr, col0 = u.pn * BM + wc * 32 + 8 * fq;
        float srw[2][4];
#pragma unroll
        for (int ai = 0; ai < 2; ++ai)
#pragma unroll
            for (int m = 0; m < 4; ++m) srw[ai][m] = rs[row0 + ai * HALF + m * 16];
#pragma unroll
        for (int ai = 0; ai < 2; ++ai)
#pragma unroll
            for (int m = 0; m < 4; ++m) { bf16_t* rowp = O + (size_t)(row0 + ai * HALF + m * 16) * ldc + col0; const float sr = srw[ai][m];
#pragma unroll
                for (int bj = 0; bj < 2; ++bj) { const f32x4 v0 = acc[ai][bj][m][0] * sr, v1 = acc[ai][bj][m][1] * sr;
                    u32x4 w; w.x = cvt_pk_bf16(v0[0], v0[1]); w.y = cvt_pk_bf16(v0[2], v0[3]); w.z = cvt_pk_bf16(v1[0], v1[1]); w.w = cvt_pk_bf16(v1[2], v1[3]);
                    *(u32x4*)(rowp + bj * HALF) = w; } }
    }
};
struct EpiScale {
    static constexpr bool I8 = false; typedef f32x4 acc_t; static constexpr bool PERM = true;
    bf16_t* O; int ldc; const float* scale;
    __device__ __forceinline__ void operator()(const f32x4 (&acc)[2][2][4][2], const Unit& u, int wr, int wc, int fr, int fq) const {
        const int row0 = u.pm * BM + wr * 64 + fr, col0 = u.pn * BM + wc * 32 + 8 * fq;
        f32x4 sv[2][2];
#pragma unroll
        for (int bj = 0; bj < 2; ++bj)
#pragma unroll
            for (int n = 0; n < 2; ++n) sv[bj][n] = *(const f32x4*)(scale + col0 + bj * HALF + 4 * n);
#pragma unroll
        for (int ai = 0; ai < 2; ++ai)
#pragma unroll
            for (int m = 0; m < 4; ++m) { bf16_t* rowp = O + (size_t)(row0 + ai * HALF + m * 16) * ldc + col0;
#pragma unroll
                for (int bj = 0; bj < 2; ++bj) { const f32x4 v0 = acc[ai][bj][m][0] * sv[bj][0], v1 = acc[ai][bj][m][1] * sv[bj][1];
                    u32x4 w; w.x = cvt_pk_bf16(v0[0], v0[1]); w.y = cvt_pk_bf16(v0[2], v0[3]); w.z = cvt_pk_bf16(v1[0], v1[1]); w.w = cvt_pk_bf16(v1[2], v1[3]);
                    *(u32x4*)(rowp + bj * HALF) = w; } }
    }
};
template <bool ADD> struct EpiGate {
    static constexpr bool I8 = false; typedef f32x4 acc_t; static constexpr bool PERM = true;
    bf16_t* O; const bf16_t* G;
    __device__ __forceinline__ void operator()(const f32x4 (&acc)[2][2][4][2], const Unit& u, int wr, int wc, int fr, int fq) const {
        const int row0 = u.pm * BM + wr * 64 + fr, ct = u.pn * BM, t = ct >> 11;
        const bf16_t* gbase = G + (size_t)t * ZSLOT; const int gcol0 = (ct & 2047) + wc * 32 + 8 * fq, col0 = ct + wc * 32 + 8 * fq;
        u32x4 gw[2][2], ow[2][2];
#define EG_LOAD(slot, g_) do { const size_t r_ = (size_t)(row0 + ((g_) >> 2) * HALF + ((g_) & 3) * 16); \
            gw[slot][0] = *(const u32x4*)(gbase + r_ * 2048 + gcol0); gw[slot][1] = *(const u32x4*)(gbase + r_ * 2048 + gcol0 + HALF); \
            if (ADD) { ow[slot][0] = *(const u32x4*)(O + r_ * 4096 + col0); ow[slot][1] = *(const u32x4*)(O + r_ * 4096 + col0 + HALF); } } while (0)
        EG_LOAD(0, 0);
#pragma unroll
        for (int g = 0; g < 8; ++g) { const int ai = g >> 2, m = g & 3, cur = g & 1;
            if (g + 1 < 8) EG_LOAD(cur ^ 1, g + 1);
            bf16_t* rowp = O + (size_t)(row0 + ai * HALF + m * 16) * 4096 + col0;
#pragma unroll
            for (int bj = 0; bj < 2; ++bj) { const u32x4 gq = gw[cur][bj];
                f32x4 v0 = acc[ai][bj][m][0], v1 = acc[ai][bj][m][1];
                v0[0] *= bflo(gq.x); v0[1] *= bfhi(gq.x); v0[2] *= bflo(gq.y); v0[3] *= bfhi(gq.y); v1[0] *= bflo(gq.z); v1[1] *= bfhi(gq.z); v1[2] *= bflo(gq.w); v1[3] *= bfhi(gq.w);
                if (ADD) { const u32x4 oq = ow[cur][bj];
                    v0[0] += bflo(oq.x); v0[1] += bfhi(oq.x); v0[2] += bflo(oq.y); v0[3] += bfhi(oq.y); v1[0] += bflo(oq.z); v1[1] += bfhi(oq.z); v1[2] += bflo(oq.w); v1[3] += bfhi(oq.w); }
                u32x4 w; w.x = cvt_pk_bf16(v0[0], v0[1]); w.y = cvt_pk_bf16(v0[2], v0[3]); w.z = cvt_pk_bf16(v1[0], v1[1]); w.w = cvt_pk_bf16(v1[2], v1[3]);
                *(u32x4*)(rowp + bj * HALF) = w; } }
#undef EG_LOAD
    }
};
struct EpiF32 {
    static constexpr bool I8 = false; typedef f32x4 acc_t; static constexpr bool PERM = false;
    float* C; int ldc; const float* base;
    __device__ __forceinline__ void operator()(const f32x4 (&acc)[2][2][4][2], const Unit& u, int wr, int wc, int fr, int fq) const {
        const int row0 = u.pm * BM + wr * 64 + fr, col0 = u.pn * BM + wc * 32 + 4 * fq;
        f32x4 bv[2][2][2];
#define EF_LOAD(slot, g_) do { const size_t off_ = (size_t)(row0 + ((g_) >> 2) * HALF + ((g_) & 3) * 16) * ldc + col0; \
            _Pragma("unroll") for (int bj = 0; bj < 2; ++bj) _Pragma("unroll") for (int n = 0; n < 2; ++n) bv[slot][bj][n] = *(const f32x4*)(base + off_ + bj * HALF + n * 16); } while (0)
        if (base) EF_LOAD(0, 0);
#pragma unroll
        for (int g = 0; g < 8; ++g) { const int ai = g >> 2, m = g & 3, cur = g & 1;
            if (base && g + 1 < 8) EF_LOAD(cur ^ 1, g + 1);
            const size_t off = (size_t)(row0 + ai * HALF + m * 16) * ldc + col0;
#pragma unroll
            for (int bj = 0; bj < 2; ++bj)
#pragma unroll
                for (int n = 0; n < 2; ++n) { f32x4 o = acc[ai][bj][m][n]; if (base) o += bv[cur][bj][n]; *(f32x4*)(C + off + bj * HALF + n * 16) = o; } }
#undef EF_LOAD
    }
};
struct EpiGelu {
    static constexpr bool I8 = false; typedef f32x4 acc_t; static constexpr bool PERM = true;
    bf16_t* O; int ldc;
    __device__ __forceinline__ void operator()(const f32x4 (&acc)[2][2][4][2], const Unit& u, int wr, int wc, int fr, int fq) const {
        const int row0 = u.pm * BM + wr * 64 + fr, col0 = u.pn * BM + wc * 32 + 8 * fq;
#pragma unroll
        for (int ai = 0; ai < 2; ++ai)
#pragma unroll
            for (int m = 0; m < 4; ++m) { bf16_t* rowp = O + (size_t)(row0 + ai * HALF + m * 16) * ldc + col0;
#pragma unroll
                for (int bj = 0; bj < 2; ++bj) { const f32x4 v0 = acc[ai][bj][m][0], v1 = acc[ai][bj][m][1];
                    const f32x2 a = gelu_pk((f32x2){v0[0], v0[1]}), b = gelu_pk((f32x2){v0[2], v0[3]}), c = gelu_pk((f32x2){v1[0], v1[1]}), d = gelu_pk((f32x2){v1[2], v1[3]});
                    u32x4 w; w.x = cvt_pk_bf16(a.x, a.y); w.y = cvt_pk_bf16(b.x, b.y); w.z = cvt_pk_bf16(c.x, c.y); w.w = cvt_pk_bf16(d.x, d.y);
                    *(u32x4*)(rowp + bj * HALF) = w; } }
    }
};

struct EpiZ8 {
    static constexpr bool I8 = true; typedef i32x4 acc_t; static constexpr bool PERM = true;
    bf16_t* Z; const float* sa; const float* sb;
    __device__ __forceinline__ void operator()(const i32x4 (&acc)[2][2][4][2], const Unit& u, int wr, int wc, int fr, int fq) const {
        const int row0 = u.pm * BM + wr * 64 + fr, ct = u.pn * BM, t = ct >> 11;
        bf16_t* base = Z + (size_t)t * ZSLOT; const int col0 = (ct & 2047) + wc * 32 + 8 * fq; const bool sig = t >= 4;
        f32x4 sv[2][2];
#pragma unroll
        for (int bj = 0; bj < 2; ++bj)
#pragma unroll
            for (int n = 0; n < 2; ++n) sv[bj][n] = *(const f32x4*)(sb + ct + wc * 32 + 8 * fq + bj * HALF + 4 * n);
        float srw[2][4];
#pragma unroll
        for (int ai = 0; ai < 2; ++ai)
#pragma unroll
            for (int m = 0; m < 4; ++m) srw[ai][m] = sa[row0 + ai * HALF + m * 16];
#pragma unroll
        for (int ai = 0; ai < 2; ++ai)
#pragma unroll
            for (int m = 0; m < 4; ++m) { const int r = row0 + ai * HALF + m * 16; const float sr = srw[ai][m]; bf16_t* rowp = base + (size_t)r * 2048 + col0;
#pragma unroll
                for (int bj = 0; bj < 2; ++bj) { f32x4 v0 = __builtin_convertvector(acc[ai][bj][m][0], f32x4) * sv[bj][0] * sr, v1 = __builtin_convertvector(acc[ai][bj][m][1], f32x4) * sv[bj][1] * sr;
                    if (sig) {
                        unsigned q[8];
#pragma unroll
                        for (int j = 0; j < 4; ++j) { q[j] = (unsigned)__builtin_rintf(sigmoidf_fast(v0[j]) * 255.f); q[4 + j] = (unsigned)__builtin_rintf(sigmoidf_fast(v1[j]) * 255.f); }
                        typedef unsigned u32x2 __attribute__((ext_vector_type(2)));
                        *(u32x2*)((unsigned char*)base + (size_t)r * 2048 + col0 + bj * HALF) = (u32x2){q[0] | (q[1] << 8) | (q[2] << 16) | (q[3] << 24), q[4] | (q[5] << 8) | (q[6] << 16) | (q[7] << 24)};
                    } else {
                        u32x4 w; w.x = cvt_pk_bf16(v0[0], v0[1]); w.y = cvt_pk_bf16(v0[2], v0[3]); w.z = cvt_pk_bf16(v1[0], v1[1]); w.w = cvt_pk_bf16(v1[2], v1[3]);
                        *(u32x4*)(rowp + bj * HALF) = w; } } }
    }
};
template <bool GELU> struct EpiAct8 {
    static constexpr bool I8 = true; typedef i32x4 acc_t; static constexpr bool PERM = true; static constexpr bool WIDE = true;
    bf16_t* O; int ldc; const float* sa; const float* sb;
    __device__ __forceinline__ void operator()(const i32x4 (&acc)[2][2][4][2], const Unit& u, int wr, int wc, int fr, int fq) const {
        const int row0 = u.pm * BM + wr * 64 + fr, col0 = u.pn * BM + wc * 64 + 16 * fq;
        f32x4 sv[2][2];
#pragma unroll
        for (int bj = 0; bj < 2; ++bj)
#pragma unroll
            for (int n = 0; n < 2; ++n) { sv[bj][n] = *(const f32x4*)(sb + col0 + bj * 8 + 4 * n); if constexpr (!GELU) sv[bj][n] = sv[bj][n] * (1.f / 16.f); }
        float srw[2][4];
#pragma unroll
        for (int ai = 0; ai < 2; ++ai)
#pragma unroll
            for (int m = 0; m < 4; ++m) srw[ai][m] = GELU ? sa[row0 + ai * HALF + m * 16] : 1.f;
#pragma unroll
        for (int ai = 0; ai < 2; ++ai)
#pragma unroll
            for (int m = 0; m < 4; ++m) { const int r = row0 + ai * HALF + m * 16; const float sr = srw[ai][m]; bf16_t* rowp = O + (size_t)r * ldc + col0;
                int pk[4] = {0, 0, 0, 0};
#pragma unroll
                for (int bj = 0; bj < 2; ++bj) { f32x4 v0 = __builtin_convertvector(acc[ai][bj][m][0], f32x4) * sv[bj][0], v1 = __builtin_convertvector(acc[ai][bj][m][1], f32x4) * sv[bj][1];
                    if constexpr (GELU) { v0 = v0 * sr; v1 = v1 * sr; }
                    if constexpr (GELU) { const f32x2 a = gelu_pk((f32x2){v0[0], v0[1]}), b = gelu_pk((f32x2){v0[2], v0[3]}), c = gelu_pk((f32x2){v1[0], v1[1]}), d = gelu_pk((f32x2){v1[2], v1[3]});
                        u32x4 w; w.x = cvt_pk_bf16(a.x, a.y); w.y = cvt_pk_bf16(b.x, b.y); w.z = cvt_pk_bf16(c.x, c.y); w.w = cvt_pk_bf16(d.x, d.y); *(u32x4*)(rowp + bj * 8) = w; }
                    else { int lo = 0, hi = 0;
                        lo = __builtin_amdgcn_cvt_pk_fp8_f32(v0[0], v0[1], lo, false); lo = __builtin_amdgcn_cvt_pk_fp8_f32(v0[2], v0[3], lo, true);
                        hi = __builtin_amdgcn_cvt_pk_fp8_f32(v1[0], v1[1], hi, false); hi = __builtin_amdgcn_cvt_pk_fp8_f32(v1[2], v1[3], hi, true);
                        pk[2 * bj] = lo; pk[2 * bj + 1] = hi; } }
                if constexpr (!GELU) *(i32x4*)((unsigned char*)O + (size_t)r * ldc + col0) = (i32x4){pk[0], pk[1], pk[2], pk[3]}; }
    }
};
struct EpiBf16_8 {
    static constexpr bool I8 = true; typedef i32x4 acc_t; static constexpr bool PERM = true;
    bf16_t* O; int ldc; const float* sa; const float* sb;
    __device__ __forceinline__ void operator()(const i32x4 (&acc)[2][2][4][2], const Unit& u, int wr, int wc, int fr, int fq) const {
        const int row0 = u.pm * BM + wr * 64 + fr, col0 = u.pn * BM + wc * 32 + 8 * fq;
        f32x4 sv[2][2];
#pragma unroll
        for (int bj = 0; bj < 2; ++bj)
#pragma unroll
            for (int n = 0; n < 2; ++n) sv[bj][n] = *(const f32x4*)(sb + col0 + bj * HALF + 4 * n);
        float srw[2][4];
#pragma unroll
        for (int ai = 0; ai < 2; ++ai)
#pragma unroll
            for (int m = 0; m < 4; ++m) srw[ai][m] = sa[row0 + ai * HALF + m * 16];
#pragma unroll
        for (int ai = 0; ai < 2; ++ai)
#pragma unroll
            for (int m = 0; m < 4; ++m) { const float sr = srw[ai][m]; bf16_t* rowp = O + (size_t)(row0 + ai * HALF + m * 16) * ldc + col0;
#pragma unroll
                for (int bj = 0; bj < 2; ++bj) { const f32x4 v0 = __builtin_convertvector(acc[ai][bj][m][0], f32x4) * sv[bj][0] * sr, v1 = __builtin_convertvector(acc[ai][bj][m][1], f32x4) * sv[bj][1] * sr;
                    u32x4 w; w.x = cvt_pk_bf16(v0[0], v0[1]); w.y = cvt_pk_bf16(v0[2], v0[3]); w.z = cvt_pk_bf16(v1[0], v1[1]); w.w = cvt_pk_bf16(v1[2], v1[3]);
                    *(u32x4*)(rowp + bj * HALF) = w; } }
    }
};
template <bool ADD> struct EpiGate8 {
    static constexpr bool I8 = true; typedef i32x4 acc_t; static constexpr bool PERM = true;
    bf16_t* O; const bf16_t* G; const float* sa; const float* sb;
    __device__ __forceinline__ void operator()(const i32x4 (&acc)[2][2][4][2], const Unit& u, int wr, int wc, int fr, int fq) const {
        const int row0 = u.pm * BM + wr * 64 + fr, ct = u.pn * BM, t = ct >> 11;
        const bf16_t* gbase = G + (size_t)t * ZSLOT; const int gcol0 = (ct & 2047) + wc * 32 + 8 * fq, col0 = ct + wc * 32 + 8 * fq;
        f32x4 sv[2][2]; float srw[8];
#pragma unroll
        for (int bj = 0; bj < 2; ++bj)
#pragma unroll
            for (int n = 0; n < 2; ++n) sv[bj][n] = *(const f32x4*)(sb + col0 + bj * HALF + 4 * n);
#pragma unroll
        for (int g = 0; g < 8; ++g) srw[g] = sa[row0 + (g >> 2) * HALF + (g & 3) * 16];
        typedef unsigned u32x2 __attribute__((ext_vector_type(2)));
        const unsigned char* gbase8 = (const unsigned char*)gbase;
        u32x2 gw[2][2]; u32x4 ow[2][2];
#define EG_LOAD(slot, g_) do { const size_t r_ = (size_t)(row0 + ((g_) >> 2) * HALF + ((g_) & 3) * 16); \
            gw[slot][0] = *(const u32x2*)(gbase8 + r_ * 2048 + gcol0); gw[slot][1] = *(const u32x2*)(gbase8 + r_ * 2048 + gcol0 + HALF); \
            if (ADD) { ow[slot][0] = *(const u32x4*)(O + r_ * 4096 + col0); ow[slot][1] = *(const u32x4*)(O + r_ * 4096 + col0 + HALF); } } while (0)
        EG_LOAD(0, 0);
#pragma unroll
        for (int g = 0; g < 8; ++g) { const int ai = g >> 2, m = g & 3, cur = g & 1;
            if (g + 1 < 8) EG_LOAD(cur ^ 1, g + 1);
            bf16_t* rowp = O + (size_t)(row0 + ai * HALF + m * 16) * 4096 + col0; const float sr = srw[g];
#pragma unroll
            for (int bj = 0; bj < 2; ++bj) { const u32x2 gq = gw[cur][bj]; const float s255 = sr * (1.f / 255.f);
                f32x4 v0 = __builtin_convertvector(acc[ai][bj][m][0], f32x4) * sv[bj][0] * s255, v1 = __builtin_convertvector(acc[ai][bj][m][1], f32x4) * sv[bj][1] * s255;
                v0[0] *= (float)(gq.x & 255u); v0[1] *= (float)((gq.x >> 8) & 255u); v0[2] *= (float)((gq.x >> 16) & 255u); v0[3] *= (float)(gq.x >> 24);
                v1[0] *= (float)(gq.y & 255u); v1[1] *= (float)((gq.y >> 8) & 255u); v1[2] *= (float)((gq.y >> 16) & 255u); v1[3] *= (float)(gq.y >> 24);
                if (ADD) { const u32x4 oq = ow[cur][bj];
                    v0[0] += bflo(oq.x); v0[1] += bfhi(oq.x); v0[2] += bflo(oq.y); v0[3] += bfhi(oq.y); v1[0] += bflo(oq.z); v1[1] += bfhi(oq.z); v1[2] += bflo(oq.w); v1[3] += bfhi(oq.w); }
                u32x4 w; w.x = cvt_pk_bf16(v0[0], v0[1]); w.y = cvt_pk_bf16(v0[2], v0[3]); w.z = cvt_pk_bf16(v1[0], v1[1]); w.w = cvt_pk_bf16(v1[2], v1[3]);
                *(u32x4*)(rowp + bj * HALF) = w; } }
#undef EG_LOAD
    }
};
struct EpiH16_8 {
    static constexpr bool I8 = true; typedef i32x4 acc_t; static constexpr bool PERM = true;
    bf16_t* O; int ldc; const float* base; const float* sa; const float* sb;
    __device__ __forceinline__ void operator()(const i32x4 (&acc)[2][2][4][2], const Unit& u, int wr, int wc, int fr, int fq) const {
        const int row0 = u.pm * BM + wr * 64 + fr, col0 = u.pn * BM + wc * 32 + 8 * fq;
        f32x4 sv[2][2]; float srw[8]; f32x4 bv[2][2][2];
#pragma unroll
        for (int bj = 0; bj < 2; ++bj)
#pragma unroll
            for (int n = 0; n < 2; ++n) sv[bj][n] = *(const f32x4*)(sb + col0 + bj * HALF + 4 * n);
#pragma unroll
        for (int g = 0; g < 8; ++g) srw[g] = sa[row0 + (g >> 2) * HALF + (g & 3) * 16];
#define EH_LOAD(slot, g_) do { const size_t off_ = (size_t)(row0 + ((g_) >> 2) * HALF + ((g_) & 3) * 16) * ldc + col0; \
            _Pragma("unroll") for (int bj = 0; bj < 2; ++bj) _Pragma("unroll") for (int n = 0; n < 2; ++n) bv[slot][bj][n] = *(const f32x4*)(base + off_ + bj * HALF + 4 * n); } while (0)
        EH_LOAD(0, 0);
#pragma unroll
        for (int g = 0; g < 8; ++g) { const int ai = g >> 2, m = g & 3, cur = g & 1;
            if (g + 1 < 8) EH_LOAD(cur ^ 1, g + 1);
            bf16_t* rowp = O + (size_t)(row0 + ai * HALF + m * 16) * ldc + col0; const float sr = srw[g];
#pragma unroll
            for (int bj = 0; bj < 2; ++bj) { const f32x4 v0 = bv[cur][bj][0] + __builtin_convertvector(acc[ai][bj][m][0], f32x4) * sv[bj][0] * sr, v1 = bv[cur][bj][1] + __builtin_convertvector(acc[ai][bj][m][1], f32x4) * sv[bj][1] * sr;
                u32x4 w; w.x = cvt_pk_bf16(v0[0], v0[1]); w.y = cvt_pk_bf16(v0[2], v0[3]); w.z = cvt_pk_bf16(v1[0], v1[1]); w.w = cvt_pk_bf16(v1[2], v1[3]);
                *(u32x4*)(rowp + bj * HALF) = w; } }
#undef EH_LOAD
    }
};
struct EpiOut8 {
    static constexpr bool I8 = true; typedef i32x4 acc_t; static constexpr bool PERM = false;
    float* C; int ldc; const bf16_t* base; const float* sa; const float* sb;
    __device__ __forceinline__ void operator()(const i32x4 (&acc)[2][2][4][2], const Unit& u, int wr, int wc, int fr, int fq) const {
        typedef unsigned u32x2 __attribute__((ext_vector_type(2)));
        const int row0 = u.pm * BM + wr * 64 + fr, col0 = u.pn * BM + wc * 32 + 4 * fq;
        f32x4 sv[2][2]; float srw[8]; u32x2 bv[2][2][2];
#pragma unroll
        for (int bj = 0; bj < 2; ++bj)
#pragma unroll
            for (int n = 0; n < 2; ++n) sv[bj][n] = *(const f32x4*)(sb + col0 + bj * HALF + n * 16);
#pragma unroll
        for (int g = 0; g < 8; ++g) srw[g] = sa[row0 + (g >> 2) * HALF + (g & 3) * 16];
#define EO_LOAD(slot, g_) do { const size_t off_ = (size_t)(row0 + ((g_) >> 2) * HALF + ((g_) & 3) * 16) * ldc + col0; \
            _Pragma("unroll") for (int bj = 0; bj < 2; ++bj) _Pragma("unroll") for (int n = 0; n < 2; ++n) bv[slot][bj][n] = *(const u32x2*)(base + off_ + bj * HALF + n * 16); } while (0)
        EO_LOAD(0, 0);
#pragma unroll
        for (int g = 0; g < 8; ++g) { const int ai = g >> 2, m = g & 3, cur = g & 1;
            if (g + 1 < 8) EO_LOAD(cur ^ 1, g + 1);
            const size_t off = (size_t)(row0 + ai * HALF + m * 16) * ldc + col0; const float sr = srw[g];
#pragma unroll
            for (int bj = 0; bj < 2; ++bj)
#pragma unroll
                for (int n = 0; n < 2; ++n) { const u32x2 bq = bv[cur][bj][n]; const f32x4 bb = {bflo(bq.x), bfhi(bq.x), bflo(bq.y), bfhi(bq.y)};
                    *(f32x4*)(C + off + bj * HALF + n * 16) = bb + __builtin_convertvector(acc[ai][bj][m][n], f32x4) * sv[bj][n] * sr; } }
#undef EO_LOAD
    }
};
struct EpiF32_8 {
    static constexpr bool I8 = true; typedef i32x4 acc_t; static constexpr bool PERM = false;
    float* C; int ldc; const float* base; const float* sa; const float* sb;
    __device__ __forceinline__ void operator()(const i32x4 (&acc)[2][2][4][2], const Unit& u, int wr, int wc, int fr, int fq) const {
        const int row0 = u.pm * BM + wr * 64 + fr, col0 = u.pn * BM + wc * 32 + 4 * fq;
        f32x4 sv[2][2]; float srw[8]; f32x4 bv[2][2][2];
#pragma unroll
        for (int bj = 0; bj < 2; ++bj)
#pragma unroll
            for (int n = 0; n < 2; ++n) sv[bj][n] = *(const f32x4*)(sb + col0 + bj * HALF + n * 16);
#pragma unroll
        for (int g = 0; g < 8; ++g) srw[g] = sa[row0 + (g >> 2) * HALF + (g & 3) * 16];
#define EF_LOAD(slot, g_) do { const size_t off_ = (size_t)(row0 + ((g_) >> 2) * HALF + ((g_) & 3) * 16) * ldc + col0; \
            _Pragma("unroll") for (int bj = 0; bj < 2; ++bj) _Pragma("unroll") for (int n = 0; n < 2; ++n) bv[slot][bj][n] = *(const f32x4*)(base + off_ + bj * HALF + n * 16); } while (0)
        EF_LOAD(0, 0);
#pragma unroll
        for (int g = 0; g < 8; ++g) { const int ai = g >> 2, m = g & 3, cur = g & 1;
            if (g + 1 < 8) EF_LOAD(cur ^ 1, g + 1);
            const size_t off = (size_t)(row0 + ai * HALF + m * 16) * ldc + col0; const float sr = srw[g];
#pragma unroll
            for (int bj = 0; bj < 2; ++bj)
#pragma unroll
                for (int n = 0; n < 2; ++n) { const f32x4 o = bv[cur][bj][n] + __builtin_convertvector(acc[ai][bj][m][n], f32x4) * sv[bj][n] * sr;
                    *(f32x4*)(C + off + bj * HALF + n * 16) = o; } }
#undef EF_LOAD
    }
};

template <class T_, class = void> struct is_wide { static constexpr bool value = false; };
template <class T_> struct is_wide<T_, decltype((void)T_::WIDE)> { static constexpr bool value = T_::WIDE; };
template <class Epi, class Sched, bool ALIGN_EPI>
__device__ __forceinline__ void gemm_phase(PG8_LAS unsigned char* lds, const Gemm g, const Sched& S, const Epi& E) {
    constexpr bool I8 = Epi::I8;
    typedef typename Epi::acc_t acc_t;
    int tid = threadIdx.x; asm volatile("" : "+v"(tid));
    const int wid = __builtin_amdgcn_readfirstlane(tid >> 6), lane = tid & 63, wr = wid >> 2, wc = wid & 3, fr = lane & 15, fq = lane >> 4;
    const int nt = g.Kb / 128;
    unsigned voffA[2], voffB[2];
    constexpr bool WIDE = is_wide<Epi>::value;
#pragma unroll
    for (int i = 0; i < 2; ++i) { int R, C; stage_rc(tid * 16 + i * 8192, R, C);
        const int Rb = WIDE ? (64 * (R >> 5) + 16 * ((R & 15) >> 2) + 4 * ((R & 31) >> 4) + (R & 3)) : Epi::PERM ? ((R & ~31) + perm32(R & 31)) : R;
        voffA[i] = (unsigned)(R * g.lda + C * 2); voffB[i] = (unsigned)(Rb * g.ldb + C * 2); }
    const size_t kstep = (size_t)128;
    const size_t hstepA = (size_t)HALF * g.lda, hstepB = (size_t)(WIDE ? 8 : HALF) * g.ldb;
    const size_t tstepA = 2 * hstepA, tstepB = (size_t)BM * g.ldb;
    const unsigned ldsw = (unsigned)wid * 1024u;
    const int aoff = lds_byte(wr * 64 + fr, fq * 8), boff = lds_byte(wc * 32 + fr, fq * 8);
#define PG8_SA(b, h) (((b) * 2 + (h)) * HTB)
#define PG8_SB(b, h) ((4 + (b) * 2 + (h)) * HTB)
#define PG8_STAGE(bufoff, gbase, voff) do { _Pragma("unroll") for (int _i = 0; _i < 2; ++_i) \
        __builtin_amdgcn_global_load_lds((const unsigned*)((const char*)(gbase) + (voff)[_i]), (PG8_LAS unsigned*)(lds + (bufoff) + ldsw + _i * 8192), 16, 0, 0); } while (0)
#define PG8_LDA(dst, b, h) do { _Pragma("unroll") for (int m = 0; m < 4; ++m) _Pragma("unroll") for (int k = 0; k < 2; ++k) dst[m][k] = *(const PG8_LAS bf16x8*)(lds + PG8_SA(b, h) + aoff + m * 2048 + k * 1024); } while (0)
#define PG8_LDB(dst, b, h) do { _Pragma("unroll") for (int n = 0; n < 2; ++n) _Pragma("unroll") for (int k = 0; k < 2; ++k) dst[n][k] = *(const PG8_LAS bf16x8*)(lds + PG8_SB(b, h) + boff + n * 2048 + k * 1024); } while (0)
#define PG8_MMA(ai, bj, At, Bt) do { __builtin_amdgcn_s_setprio(1); _Pragma("unroll") for (int m = 0; m < 4; ++m) _Pragma("unroll") for (int n = 0; n < 2; ++n) _Pragma("unroll") for (int k = 0; k < 2; ++k) { \
        if constexpr (I8) acc[ai][bj][m][n] = __builtin_amdgcn_mfma_i32_16x16x64_i8(__builtin_bit_cast(i32x4, Bt[n][k]), __builtin_bit_cast(i32x4, At[m][k]), acc[ai][bj][m][n], 0, 0, 0); \
        else acc[ai][bj][m][n] = __builtin_amdgcn_mfma_f32_16x16x32_bf16(Bt[n][k], At[m][k], acc[ai][bj][m][n], 0, 0, 0); } __builtin_amdgcn_s_setprio(0); } while (0)
#define PG8_WAIT_V(n) asm volatile("s_waitcnt vmcnt(" #n ")" ::: "memory")
#define PG8_WAIT_L(n) asm volatile("s_waitcnt lgkmcnt(" #n ")" ::: "memory")
#define PG8_BAR __builtin_amdgcn_s_barrier()
#define PG8_SCHED __builtin_amdgcn_sched_barrier(0)
    Unit cur, nxt; int ui = 0;
    if (!S.next(0, cur)) return;
    acc_t acc[2][2][4][2];
#pragma unroll
    for (int a = 0; a < 2; ++a)
#pragma unroll
        for (int b = 0; b < 2; ++b)
#pragma unroll
            for (int m = 0; m < 4; ++m)
#pragma unroll
                for (int n = 0; n < 2; ++n) acc[a][b][m][n] = (acc_t){0, 0, 0, 0};
    bf16x8 At[4][2], B0[2][2], B1[2][2];
    const char* cA = (const char*)g.A + (size_t)cur.pm * tstepA + (size_t)cur.ak; const char* cB = (const char*)g.Bt + (size_t)cur.pn * tstepB;
    PG8_STAGE(PG8_SB(0, 0), cB, voffB); PG8_STAGE(PG8_SB(0, 1), cB + hstepB, voffB); PG8_STAGE(PG8_SA(0, 0), cA, voffA); PG8_STAGE(PG8_SA(0, 1), cA + hstepA, voffA);
    if (wr == 1) PG8_BAR;
    PG8_WAIT_V(2); PG8_BAR;
    PG8_STAGE(PG8_SB(1, 0), cB + kstep, voffB); PG8_STAGE(PG8_SA(1, 0), cA + kstep, voffA); PG8_STAGE(PG8_SB(1, 1), cB + hstepB + kstep, voffB);
    PG8_WAIT_V(6); PG8_BAR;
    for (;;) {
        const bool has_next = S.next(ui + 1, nxt);
        const char* nA = has_next ? (const char*)g.A + (size_t)nxt.pm * tstepA + (size_t)nxt.ak : cA; const char* nB = has_next ? (const char*)g.Bt + (size_t)nxt.pn * tstepB : cB;
        for (int t = 0; t < nt; t += 2) {
            const bool last = (t == nt - 2);
            const char* a1 = cA + (size_t)(t + 1) * kstep;
            const char* a2 = last ? nA : cA + (size_t)(t + 2) * kstep; const char* b2 = last ? nB : cB + (size_t)(t + 2) * kstep;
            const char* a3 = a2 + kstep; const char* b3 = b2 + kstep;
            PG8_LDB(B0, 0, 0); PG8_LDB(B1, 0, 1); PG8_SCHED; PG8_LDA(At, 0, 0); PG8_STAGE(PG8_SA(1, 1), a1 + hstepA, voffA);
            PG8_WAIT_V(8); PG8_WAIT_L(0); PG8_BAR; PG8_MMA(0, 0, At, B0); PG8_MMA(0, 1, At, B1); PG8_BAR; PG8_SCHED;
            PG8_LDA(At, 0, 1); PG8_STAGE(PG8_SB(0, 0), b2, voffB); PG8_STAGE(PG8_SB(0, 1), b2 + hstepB, voffB); PG8_STAGE(PG8_SA(0, 0), a2, voffA);
            PG8_WAIT_V(8); PG8_WAIT_L(0); PG8_BAR; PG8_MMA(1, 0, At, B0); PG8_MMA(1, 1, At, B1); PG8_BAR; PG8_SCHED;
            PG8_LDB(B0, 1, 0); PG8_LDB(B1, 1, 1); PG8_SCHED; PG8_LDA(At, 1, 0); PG8_STAGE(PG8_SA(0, 1), a2 + hstepA, voffA);
            PG8_WAIT_V(8); PG8_WAIT_L(0); PG8_BAR; PG8_MMA(0, 0, At, B0); PG8_MMA(0, 1, At, B1); PG8_BAR; PG8_SCHED;
            PG8_LDA(At, 1, 1); PG8_STAGE(PG8_SB(1, 0), b3, voffB); PG8_STAGE(PG8_SB(1, 1), b3 + hstepB, voffB); PG8_STAGE(PG8_SA(1, 0), a3, voffA);
            PG8_WAIT_V(8); PG8_WAIT_L(0); PG8_BAR; PG8_MMA(1, 0, At, B0); PG8_MMA(1, 1, At, B1); PG8_BAR; PG8_SCHED;
        }
        if constexpr (ALIGN_EPI) { if (wr == 0) PG8_BAR; }
        E(acc, cur, wr, wc, fr, fq);
        if (!has_next) break;
#pragma unroll
        for (int a = 0; a < 2; ++a)
#pragma unroll
            for (int b = 0; b < 2; ++b)
#pragma unroll
                for (int m = 0; m < 4; ++m)
#pragma unroll
                    for (int n = 0; n < 2; ++n) acc[a][b][m][n] = (acc_t){0, 0, 0, 0};
        cur = nxt; cA = nA; cB = nB; ++ui;
        if constexpr (ALIGN_EPI) { if (wr == 1) PG8_BAR; }
    }
    PG8_WAIT_V(0);
    if constexpr (!ALIGN_EPI) { if (wr == 0) PG8_BAR; }
    PG8_BAR;
#undef PG8_SA
#undef PG8_SB
#undef PG8_STAGE
#undef PG8_LDA
#undef PG8_LDB
#undef PG8_MMA
#undef PG8_WAIT_V
#undef PG8_WAIT_L
#undef PG8_BAR
#undef PG8_SCHED
}
}

namespace att {
constexpr int D = 128, LD = 2048, NW = 8, QBLK = 32, KVBLK = 64, QB = NW * QBLK;
constexpr float SCALE = 0.08838834764831845f;
constexpr float THR = 8.f;
constexpr int SHM_V = KVBLK * D * 2, SHM_K = KVBLK * D * 2;
constexpr int SEQ_ = 4096;
__device__ __forceinline__ unsigned f2bf_(float f) { unsigned u = __float_as_uint(f); return (u + 0x7fffu + ((u >> 16) & 1u)) >> 16; }
constexpr int NRING = 4;
constexpr int ATT_LDS_BYTES = NRING * SHM_V + NRING * SHM_K + NW * 64 * 4 + 2 * 32 * 256;
typedef short bf16x8 __attribute__((ext_vector_type(8)));
typedef short s16x4 __attribute__((ext_vector_type(4)));
typedef float f32x16 __attribute__((ext_vector_type(16)));
typedef float f32x4 __attribute__((ext_vector_type(4)));
typedef unsigned u32x4 __attribute__((ext_vector_type(4)));
typedef unsigned short bf16;

#define KSWZ(row, colB) ((row) * 256 + ((colB) ^ (((row) & 7) << 4)))
#define SBAR() __builtin_amdgcn_sched_barrier(0)
__device__ __forceinline__ int v_st(int k, int c) { const int kk = (k & ~0xC) | ((k & 4) << 1) | ((k & 8) >> 1); return ((kk >> 3) * 4 + (c >> 5)) * 512 + ((kk & 7) * 32 + (c & 31)) * 2; }
__device__ __forceinline__ int v_rd_base(int lane) { return ((lane & 3) << 3) | (((lane >> 2) & 3) << 6) | (((lane >> 4) & 1) << 5) | (((lane >> 5) & 1) << 8); }
constexpr int v_rd_off(int d0, int ks, int half) { return d0 * 512 + ks * 4096 + half * 2048; }
__device__ __forceinline__ int crow(int r, int hi) { return (r & 3) + 8 * (r >> 2) + 4 * hi; }
__device__ __forceinline__ unsigned cvtpk(float lo, float hi) { unsigned r; asm volatile("v_cvt_pk_bf16_f32 %0, %1, %2" : "=v"(r) : "v"(lo), "v"(hi)); return r; }
__device__ __forceinline__ bf16x8 load8(const bf16* p) { return *reinterpret_cast<const bf16x8*>(p); }
__device__ __forceinline__ void mask_tile(f32x16& p0, f32x16& p1, int dq) {
    const float NEG = -__builtin_inff();
#pragma unroll
    for (int r = 0; r < 16; ++r) {
        const int c = (r & 3) + 8 * (r >> 2);
        if (dq - c < 0) p0[r] = NEG;
        if (dq - c - 32 < 0) p1[r] = NEG;
    }
}
__device__ __forceinline__ void mask_all(f32x16& p0, f32x16& p1, bool keep) {
    const float NEG = -__builtin_inff();
#pragma unroll
    for (int r = 0; r < 16; ++r) { p0[r] = keep ? p0[r] : NEG; p1[r] = keep ? p1[r] : NEG; }
}
__device__ __forceinline__ void partialSM(f32x16& p0, f32x16& p1, float& m_reg, float& mn, float& alpha) {
    float pmax = p0[0]; for (int r = 1; r < 16; ++r) pmax = fmaxf(pmax, p0[r]); for (int r = 0; r < 16; ++r) pmax = fmaxf(pmax, p1[r]);
    { auto rr = __builtin_amdgcn_permlane32_swap(__float_as_uint(pmax), __float_as_uint(pmax), false, false);
      pmax = fmaxf(__uint_as_float(rr[0]), __uint_as_float(rr[1])); }
    constexpr float C2 = 1.4426950408889634f * SCALE;
    if (__builtin_expect(__all((pmax - m_reg) * SCALE <= THR), 1)) { mn = m_reg; alpha = 1.f; }
    else { mn = fmaxf(m_reg, pmax); alpha = __builtin_amdgcn_exp2f((m_reg - mn) * C2); m_reg = mn; }
    const float mnL = -mn * C2;
    for (int r = 0; r < 16; ++r) p0[r] = fmaf(p0[r], C2, mnL); for (int r = 0; r < 16; ++r) p1[r] = fmaf(p1[r], C2, mnL);
    for (int r = 0; r < 16; ++r) p0[r] = __builtin_amdgcn_exp2f(p0[r]);
}
__device__ __forceinline__ void finishSM(f32x16& p0, f32x16& p1, float alpha, float& l_reg, bf16x8& pa0, bf16x8& pa1, bf16x8& pa2, bf16x8& pa3) {
    for (int r = 0; r < 16; ++r) p1[r] = __builtin_amdgcn_exp2f(p1[r]);
    float ps = 0; for (int r = 0; r < 16; ++r) ps += p0[r]; for (int r = 0; r < 16; ++r) ps += p1[r];
    { auto rr = __builtin_amdgcn_permlane32_swap(__float_as_uint(ps), __float_as_uint(ps), false, false);
      ps = __uint_as_float(rr[0]) + __uint_as_float(rr[1]); }
    l_reg = l_reg * alpha + ps;
#define PK4(P, B_, OUT) do { unsigned a0 = cvtpk(P[B_+0], P[B_+1]), a1 = cvtpk(P[B_+2], P[B_+3]);                          \
        unsigned b0 = cvtpk(P[B_+4], P[B_+5]), b1 = cvtpk(P[B_+6], P[B_+7]);                                             \
        auto r0 = __builtin_amdgcn_permlane32_swap(a0, b0, false, false); auto r1 = __builtin_amdgcn_permlane32_swap(a1, b1, false, false); \
        u32x4 w = {r0[0], r1[0], r0[1], r1[1]}; OUT = *reinterpret_cast<bf16x8*>(&w); } while (0)
    PK4(p0, 0, pa0); PK4(p0, 8, pa1); PK4(p1, 0, pa2); PK4(p1, 8, pa3);
#undef PK4
}
__device__ __forceinline__ void qkt(f32x16& p0, f32x16& p1, const char* K_slot, int r32, int hi, const bf16x8* qr) {
    p0 = f32x16{}; p1 = f32x16{};
    int kb[4];
#pragma unroll
    for (int dd = 0; dd < 4; ++dd) kb[dd] = (int)(uintptr_t)K_slot + KSWZ(r32, (dd * 16 + hi * 8) * 2);
#define KRD(dst, d0) do { asm volatile("ds_read_b128 %0, %1 offset:%2" : "=&v"(dst##0) : "v"(kb[(d0) & 3]), "i"(((d0) >> 2) * 128) : "memory"); \
                          asm volatile("ds_read_b128 %0, %1 offset:%2" : "=&v"(dst##1) : "v"(kb[(d0) & 3]), "i"(((d0) >> 2) * 128 + 32 * 256) : "memory"); } while (0)
#define KWAIT(n, f) asm volatile("s_waitcnt lgkmcnt(" #n ")" : "+v"(f##0), "+v"(f##1) :: "memory")
#define KMMA(f, d0) do { SBAR(); p0 = __builtin_amdgcn_mfma_f32_32x32x16_bf16(f##0, qr[d0], p0, 0, 0, 0); p1 = __builtin_amdgcn_mfma_f32_32x32x16_bf16(f##1, qr[d0], p1, 0, 0, 0); asm volatile("" : "+v"(p0), "+v"(p1)); SBAR(); } while (0)
    bf16x8 fa0, fa1, fb0, fb1, fc0, fc1;
    KRD(fa, 0); KRD(fb, 1);
    KRD(fc, 2); KWAIT(4, fa); KMMA(fa, 0);
    KRD(fa, 3); KWAIT(4, fb); KMMA(fb, 1);
    KRD(fb, 4); KWAIT(4, fc); KMMA(fc, 2);
    KRD(fc, 5); KWAIT(4, fa); KMMA(fa, 3);
    KRD(fa, 6); KWAIT(4, fb); KMMA(fb, 4);
    KRD(fb, 7); KWAIT(4, fc); KMMA(fc, 5);
    KWAIT(2, fa); KMMA(fa, 6);
    KWAIT(0, fb); KMMA(fb, 7);
#undef KRD
#undef KWAIT
#undef KMMA
}
template <bool PIPE>
__device__ __forceinline__ void pv_tile(f32x16* o, int vb0, bf16x8 pa0, bf16x8 pa1, bf16x8 pa2, bf16x8 pa3) {
#define TRRD(dst, off) asm volatile("ds_read_b64_tr_b16 %0, %1 offset:%2" : "=&v"(dst) : "v"(vb0), "i"(off) : "memory")
#define PV_ISSUE(x, g) do { constexpr int b_ = v_rd_off((g) >> 1, 0, 0) + ((g) & 1) * 8192; TRRD(x##l0, b_); TRRD(x##h0, b_ + 2048); TRRD(x##l1, b_ + 4096); TRRD(x##h1, b_ + 6144); } while (0)
#define PV_WAIT(n, x) asm volatile("s_waitcnt lgkmcnt(" #n ")" : "+v"(x##l0), "+v"(x##h0), "+v"(x##l1), "+v"(x##h1) :: "memory")
#define PV_MMA(x, g) do { SBAR(); \
        o[(g) >> 1] = __builtin_amdgcn_mfma_f32_32x32x16_bf16(((g) & 1) ? pa2 : pa0, (bf16x8){x##l0[0], x##l0[1], x##l0[2], x##l0[3], x##h0[0], x##h0[1], x##h0[2], x##h0[3]}, o[(g) >> 1], 0, 0, 0); \
        o[(g) >> 1] = __builtin_amdgcn_mfma_f32_32x32x16_bf16(((g) & 1) ? pa3 : pa1, (bf16x8){x##l1[0], x##l1[1], x##l1[2], x##l1[3], x##h1[0], x##h1[1], x##h1[2], x##h1[3]}, o[(g) >> 1], 0, 0, 0); asm volatile("" : "+v"(o[(g) >> 1])); SBAR(); } while (0)
    if constexpr (!PIPE) {
        s16x4 al0, ah0, al1, ah1;
        PV_ISSUE(a, 0); PV_WAIT(0, a); PV_MMA(a, 0); PV_ISSUE(a, 1); PV_WAIT(0, a); PV_MMA(a, 1); PV_ISSUE(a, 2); PV_WAIT(0, a); PV_MMA(a, 2); PV_ISSUE(a, 3); PV_WAIT(0, a); PV_MMA(a, 3);
        PV_ISSUE(a, 4); PV_WAIT(0, a); PV_MMA(a, 4); PV_ISSUE(a, 5); PV_WAIT(0, a); PV_MMA(a, 5); PV_ISSUE(a, 6); PV_WAIT(0, a); PV_MMA(a, 6); PV_ISSUE(a, 7); PV_WAIT(0, a); PV_MMA(a, 7);
        return;
    }
    s16x4 al0, ah0, al1, ah1, bl0, bh0, bl1, bh1;
    PV_ISSUE(a, 0);
    PV_ISSUE(b, 1); PV_WAIT(4, a); PV_MMA(a, 0);
    PV_ISSUE(a, 2); PV_WAIT(4, b); PV_MMA(b, 1);
    PV_ISSUE(b, 3); PV_WAIT(4, a); PV_MMA(a, 2);
    PV_ISSUE(a, 4); PV_WAIT(4, b); PV_MMA(b, 3);
    PV_ISSUE(b, 5); PV_WAIT(4, a); PV_MMA(a, 4);
    PV_ISSUE(a, 6); PV_WAIT(4, b); PV_MMA(b, 5);
    PV_ISSUE(b, 7); PV_WAIT(4, a); PV_MMA(a, 6);
    PV_WAIT(0, b); PV_MMA(b, 7);
#undef PV_ISSUE
#undef PV_WAIT
#undef PV_MMA
#undef TRRD
}

struct BlockRef { int tok0, h, P0; };
struct Bases { bf16* zq; const bf16* zk; const bf16* zv; const float* kmean; const float* qgain; const float* rcos; const float* rsin; };
#define REF_Q(r) (B.zq + (size_t)((r).tok0 + (r).P0) * LD + (r).h * D)
#define REF_K(r) (B.zk + (size_t)(r).tok0 * LD + (r).h * D)
#define REF_V(r) (B.zv + (size_t)(r).tok0 * LD + (r).h * D)
struct Seam { bf16x8 qr[8]; f32x4 km; int ring; };
#define VMW() asm volatile("s_waitcnt vmcnt(0)" ::: "memory")
#define VMWN(n) asm volatile("s_waitcnt vmcnt(%0)" :: "i"(n) : "memory")
struct DmaOff { int k0, k1, v0, v1; };
__device__ __forceinline__ DmaOff dma_offsets(int wid, int lane) {
    DmaOff d;
    { const int k = 8 * wid + (lane >> 4); d.k0 = k * (LD * 2) + (((lane & 15) * 16) ^ ((k & 7) << 4)); const int k2 = k + 4; d.k1 = k2 * (LD * 2) + (((lane & 15) * 16) ^ ((k2 & 7) << 4)); }
#pragma unroll
    for (int i = 0; i < 2; ++i) { const int q = 2 * wid + i, blk = 2 * q + (lane >> 5), g = lane & 31, kk = (blk >> 2) * 8 + (g >> 2), k = (kk & ~0xC) | ((kk & 4) << 1) | ((kk & 8) >> 1), c = (blk & 3) * 32 + (g & 3) * 8;
        const int off = k * (LD * 2) + c * 2; if (i == 0) d.v0 = off; else d.v1 = off; }
    return d;
}
#define DMA16(gp, lp) __builtin_amdgcn_global_load_lds((const unsigned*)(gp), (__attribute__((address_space(3))) unsigned*)(lp), 16, 0, 0)
#define DMA_TILE(Kp, Vp, k0_, so) do { const char* kb_ = (const char*)(Kp) + (size_t)(k0_) * (LD * 2); const char* vb_ = (const char*)(Vp) + (size_t)(k0_) * (LD * 2); \
        char* kl_ = K_lds + (so) + wid * 2048; char* vl_ = V_lds + (so) + wid * 2048; \
        DMA16(kb_ + DO.k0, kl_); DMA16(kb_ + DO.k1, kl_ + 1024); DMA16(vb_ + DO.v0, vl_); DMA16(vb_ + DO.v1, vl_ + 1024); } while (0)
__device__ __forceinline__ void moba_prime(const Bases& B, const BlockRef& cur, char* lds, Seam& S) {
    int tid = threadIdx.x; asm volatile("" : "+v"(tid));
    const int wid = __builtin_amdgcn_readfirstlane(tid >> 6), lane = tid & 63, r32 = lane & 31, hi = lane >> 5;
    char* V_lds = lds; char* K_lds = lds + NRING * SHM_V; const DmaOff DO = dma_offsets(wid, lane);
    { const bf16* Qp = REF_Q(cur);
    for (int d0 = 0; d0 < 8; ++d0) S.qr[d0] = load8(Qp + (size_t)(wid * QBLK + r32) * LD + d0 * 16 + hi * 8); }
    S.km = *(const f32x4*)(B.kmean + ((size_t)((cur.tok0 / SEQ_) * 16 + cur.h) * 16) * D + (tid >> 5) * D + (tid & 31) * 4);
    { const bf16* Kp = REF_K(cur); const bf16* Vp = REF_V(cur); DMA_TILE(Kp, Vp, 0, 0); DMA_TILE(Kp, Vp, KVBLK, SHM_K); } S.ring = 0;
}
__device__ __forceinline__ void moba_block(const Bases& B, const BlockRef& cur, const BlockRef& nxt, char* lds, Seam& S) {
    int tid = threadIdx.x; asm volatile("" : "+v"(tid));
    const int wid = __builtin_amdgcn_readfirstlane(tid >> 6), lane = tid & 63, r32 = lane & 31, hi = lane >> 5;
    const int NT = cur.P0 / KVBLK + 4;
    const int qlo = cur.P0 + wid * QBLK, qm = qlo + r32 - 4 * hi;
    { const int pos = cur.P0 + wid * QBLK + r32;
      float ss = 0.f;
#pragma unroll
      for (int d0 = 0; d0 < 8; ++d0)
#pragma unroll
          for (int j = 0; j < 8; ++j) { const float f = __uint_as_float((unsigned)(unsigned short)S.qr[d0][j] << 16); ss += f * f; }
      { const auto rr = __builtin_amdgcn_permlane32_swap(__float_as_uint(ss), __float_as_uint(ss), false, false); const unsigned a0 = rr[0], a1 = rr[1]; ss = __uint_as_float(a0) + __uint_as_float(a1); }
      const float rn = 1.f / sqrtf(ss * (1.f / D) + 1e-6f);
#pragma unroll
      for (int d0 = 0; d0 < 4; ++d0) { const int c0 = d0 * 16 + hi * 8;
          const f32x4 ga0 = *(const f32x4*)(B.qgain + c0), ga1 = *(const f32x4*)(B.qgain + c0 + 4), gb0 = *(const f32x4*)(B.qgain + 64 + c0), gb1 = *(const f32x4*)(B.qgain + 64 + c0 + 4);
          const f32x4 cs0 = *(const f32x4*)(B.rcos + pos * 64 + c0), cs1 = *(const f32x4*)(B.rcos + pos * 64 + c0 + 4), sn0 = *(const f32x4*)(B.rsin + pos * 64 + c0), sn1 = *(const f32x4*)(B.rsin + pos * 64 + c0 + 4);
          float oa[8], ob[8];
#pragma unroll
          for (int j = 0; j < 8; ++j) { const float ga = j < 4 ? ga0[j & 3] : ga1[j & 3], gb = j < 4 ? gb0[j & 3] : gb1[j & 3], cc = j < 4 ? cs0[j & 3] : cs1[j & 3], sn = j < 4 ? sn0[j & 3] : sn1[j & 3];
              const float a = __uint_as_float((unsigned)(unsigned short)S.qr[d0][j] << 16) * rn * ga, b = __uint_as_float((unsigned)(unsigned short)S.qr[d0 + 4][j] << 16) * rn * gb;
              oa[j] = a * cc - b * sn; ob[j] = b * cc + a * sn; }
          u32x4 wa = {cvtpk(oa[0], oa[1]), cvtpk(oa[2], oa[3]), cvtpk(oa[4], oa[5]), cvtpk(oa[6], oa[7])}, wb = {cvtpk(ob[0], ob[1]), cvtpk(ob[2], ob[3]), cvtpk(ob[4], ob[5]), cvtpk(ob[6], ob[7])};
          S.qr[d0] = *reinterpret_cast<bf16x8*>(&wa); S.qr[d0 + 4] = *reinterpret_cast<bf16x8*>(&wb); } }
    unsigned selv;
    { const int qb = cur.P0 >> 8;
      if (qb <= 3) selv = (1u << qb) - 1u;
      else {
        char* KMh = lds + NRING * SHM_V + NRING * SHM_K + NW * 64 * 4; char* KMl = KMh + 32 * 256;
        { const int n = tid >> 5, c4 = (tid & 31) * 4;
          const f32x4 v = S.km;
          const unsigned h0 = f2bf_(v[0]), h1 = f2bf_(v[1]), h2 = f2bf_(v[2]), h3 = f2bf_(v[3]);
          const unsigned l0 = f2bf_(v[0] - __uint_as_float(h0 << 16)), l1 = f2bf_(v[1] - __uint_as_float(h1 << 16)), l2 = f2bf_(v[2] - __uint_as_float(h2 << 16)), l3 = f2bf_(v[3] - __uint_as_float(h3 << 16));
          typedef unsigned u32x2_ __attribute__((ext_vector_type(2)));
          *(u32x2_*)(KMh + KSWZ(n, c4 * 2)) = (u32x2_){h0 | (h1 << 16), h2 | (h3 << 16)}; *(u32x2_*)(KMl + KSWZ(n, c4 * 2)) = (u32x2_){l0 | (l1 << 16), l2 | (l3 << 16)}; }
        __syncthreads();
        f32x16 g = f32x16{};
#pragma unroll
        for (int d0 = 0; d0 < 8; ++d0) { const int off = KSWZ(r32, d0 * 32 + hi * 16);
            g = __builtin_amdgcn_mfma_f32_32x32x16_bf16(*reinterpret_cast<const bf16x8*>(KMh + off), S.qr[d0], g, 0, 0, 0);
            g = __builtin_amdgcn_mfma_f32_32x32x16_bf16(*reinterpret_cast<const bf16x8*>(KMl + off), S.qr[d0], g, 0, 0, 0); }
        float dsc[16];
#pragma unroll
        for (int r = 0; r < 8; ++r) { const float f = g[r]; const auto rr = __builtin_amdgcn_permlane32_swap(__float_as_uint(f), __float_as_uint(f), false, false);
            const unsigned a0 = rr[0], a1 = rr[1]; dsc[(r & 3) + 8 * (r >> 2)] = __uint_as_float(a0); dsc[(r & 3) + 8 * (r >> 2) + 4] = __uint_as_float(a1); }
        float b0 = -3e38f, b1 = -3e38f, b2 = -3e38f; int i0 = 0, i1 = 0, i2 = 0;
#pragma unroll
        for (int n = 0; n < 15; ++n) if (n < qb) { const float dd = dsc[n];
            if (dd > b0) { b2 = b1; i2 = i1; b1 = b0; i1 = i0; b0 = dd; i0 = n; }
            else if (dd > b1) { b2 = b1; i2 = i1; b1 = dd; i1 = n; }
            else if (dd > b2) { b2 = dd; i2 = n; } }
        selv = (1u << i0) | (1u << i1) | (1u << i2);
      } }
    char* V_lds = lds; char* K_lds = lds + NRING * SHM_V;
    float* ws = (float*)(lds + NRING * SHM_V + NRING * SHM_K) + wid * 64; float* li_l = ws, * al_l = ws + 32;
    float m_reg = -1e30f, l_reg = 0; f32x16 o[4] = {};
    const DmaOff DO = dma_offsets(wid, lane);
    const int vb0 = (int)(uintptr_t)V_lds + v_rd_base(lane);
    const bf16* Kh = REF_K(cur); const bf16* Vh = REF_V(cur);
    int sK = S.ring * SHM_K, sN = ((S.ring + 1) & 3) * SHM_K, sF = ((S.ring + 2) & 3) * SHM_K, sP = ((S.ring + 3) & 3) * SHM_K;
    if (wid < 4) __builtin_amdgcn_s_setprio(2);
#define ROTATE() do { const int t_ = sP; sP = sK; sK = sN; sN = sF; sF = t_; } while (0)
#define RESC(a) do { if (__any((a) < 1.f)) { if (hi == 0) al_l[r32] = (a); asm volatile("s_waitcnt lgkmcnt(0)" ::: "memory");              \
                     for (int d_ = 0; d_ < 4; ++d_) for (int r = 0; r < 16; ++r) o[d_][r] *= al_l[crow(r, hi)]; } } while (0)
#define KBASE(t) ((t) * KVBLK)
#define MASKT(P0_, P1_, t) do { const int kb_ = KBASE(t); \
        if (kb_ < cur.P0) { const bool keep_ = ((selv >> (kb_ >> 8)) & 1u) != 0u; if (!__all(keep_)) mask_all(P0_, P1_, keep_); } \
        else if (kb_ + KVBLK - 1 > qlo) mask_tile(P0_, P1_, qm - kb_); } while (0)
    f32x16 pA0, pA1, pB0, pB1; float mnA, mnB, alA, alB; bf16x8 pa0, pa1, pa2, pa3;
    VMW(); __syncthreads();
    DMA_TILE(Kh, Vh, KBASE(2), sF);
    SBAR(); qkt(pA0, pA1, K_lds + sK, r32, hi, S.qr); SBAR();
    MASKT(pA0, pA1, 0); partialSM(pA0, pA1, m_reg, mnA, alA);
    ROTATE();
#define HALF_STEP(PX0, PX1, mnX, alX, PY0, PY1, alY, t) do {                                                                  \
        SBAR(); if ((t) + 2 < NT) { DMA_TILE(Kh, Vh, KBASE((t) + 2), sF); SBAR(); }                            \
        qkt(PX0, PX1, K_lds + sK, r32, hi, S.qr);                                                                     \
        finishSM(PY0, PY1, alY, l_reg, pa0, pa1, pa2, pa3); SBAR();                                                           \
        pv_tile<true>(o, vb0 + sP, pa0, pa1, pa2, pa3); MASKT(PX0, PX1, (t)); partialSM(PX0, PX1, m_reg, mnX, alX);           \
        if ((t) + 2 < NT) VMWN(4); else VMW();                         \
        RESC(alX); __syncthreads(); ROTATE(); } while (0)
    for (int t = 1; t + 1 < NT; t += 2) {
        HALF_STEP(pB0, pB1, mnB, alB, pA0, pA1, alA, t);
        HALF_STEP(pA0, pA1, mnA, alA, pB0, pB1, alB, t + 1);
    }
    { SBAR(); qkt(pB0, pB1, K_lds + sK, r32, hi, S.qr); SBAR(); }
    { const bf16* Kn = REF_K(nxt); const bf16* Vn = REF_V(nxt); DMA_TILE(Kn, Vn, 0, sN); DMA_TILE(Kn, Vn, KVBLK, sF); } SBAR();
    { int qrow_ = wid * QBLK + r32; asm volatile("" : "+v"(qrow_));
      const bf16* Qn = REF_Q(nxt) + (size_t)qrow_ * LD + hi * 8;
#pragma unroll
    for (int d0 = 0; d0 < 8; ++d0) S.qr[d0] = load8(Qn + d0 * 16); }
    { int kmo_ = (tid >> 5) * D + (tid & 31) * 4; asm volatile("" : "+v"(kmo_));
      S.km = *(const f32x4*)(B.kmean + ((size_t)((nxt.tok0 / SEQ_) * 16 + nxt.h) * 16) * D + kmo_); }
    SBAR();
    finishSM(pA0, pA1, alA, l_reg, pa0, pa1, pa2, pa3); SBAR();
    pv_tile<true>(o, vb0 + sP, pa0, pa1, pa2, pa3);
    { MASKT(pB0, pB1, NT - 1); partialSM(pB0, pB1, m_reg, mnB, alB); RESC(alB);
      finishSM(pB0, pB1, alB, l_reg, pa0, pa1, pa2, pa3); SBAR(); pv_tile<true>(o, vb0 + sK, pa0, pa1, pa2, pa3); }
    S.ring = __builtin_amdgcn_readfirstlane(sN / SHM_K);
    if (hi == 0) li_l[r32] = l_reg; asm volatile("s_waitcnt lgkmcnt(0)" ::: "memory");
    float rli[16];
#pragma unroll
    for (int r = 0; r < 16; ++r) rli[r] = __builtin_amdgcn_rcpf(li_l[crow(r, hi)]);
    int ocol_ = hi * 4 * LD + r32; asm volatile("" : "+v"(ocol_));
    bf16* Ow = REF_Q(cur) + (size_t)(wid * QBLK) * LD + ocol_;
#pragma unroll
    for (int r = 0; r < 16; ++r) { const int orow = (r & 3) + 8 * (r >> 2);
#pragma unroll
        for (int d0 = 0; d0 < 4; ++d0) { const float v = o[d0][r] * rli[r];
            const float vn = __shfl_xor(v, 1);
            if ((r32 & 1) == 0) *(unsigned*)(Ow + (size_t)orow * LD + d0 * 32) = cvtpk(v, vn); } }
    __builtin_amdgcn_s_setprio(0);
    __syncthreads();
#undef RESC
#undef KBASE
#undef MASKT
#undef HALF_STEP
#undef ROTATE
}
#undef REF_Q
#undef REF_K
#undef REF_V
#undef VMW
#undef VMWN
#undef DMA16
#undef DMA_TILE
#undef KSWZ
#undef SBAR
}

#define XB_TMO      128
#define XB_XCNT(j)  (256  + 64 * (j))
#define XB_XSUB(j)  (1280 + 64 * (j))
#define XB_XGEN(j)  (2304 + 64 * (j))
#define XB_TOP      3328
#define XB_TOPGEN   3392
#define XCD_BAR_WORDS 3456
#define XB_SPIN_CAP (1u << 18)
__device__ __forceinline__ unsigned xb_ld(unsigned* p)              { return __hip_atomic_load(p, __ATOMIC_RELAXED, __HIP_MEMORY_SCOPE_AGENT); }
__device__ __forceinline__ unsigned xb_add(unsigned* p, unsigned v) { return __hip_atomic_fetch_add(p, v, __ATOMIC_RELAXED, __HIP_MEMORY_SCOPE_AGENT); }
__device__ __forceinline__ unsigned xb_xcc_id() { return (unsigned)__builtin_amdgcn_s_getreg((3 << 11) | 20) & 0xFu; }
#define XB_SPIN(cond, bar) do { unsigned _sp = 0; while (cond) { __builtin_amdgcn_s_sleep(1); \
    if ((++_sp & 255u) == 0u) { if (xb_ld(&(bar)[XB_TMO])) break; if (_sp > XB_SPIN_CAP) { atomicAdd(&(bar)[XB_TMO], 1u); break; } } } } while (0)
struct XcdBarrier { unsigned* bar; unsigned x; volatile LAS unsigned* st; };
__device__ __forceinline__ XcdBarrier xcd_barrier_post(unsigned* bar, volatile LAS unsigned* st) {
    XcdBarrier b; b.bar = bar; b.x = xb_xcc_id(); b.st = st;
    if (threadIdx.x == 0) (void)xb_add(&bar[XB_XCNT(b.x)], 1u);
    return b;
}
__device__ __forceinline__ void xcd_barrier_complete(unsigned* bar, unsigned x, unsigned& nloc, unsigned& nx) {
    const unsigned G = gridDim.x * gridDim.y * gridDim.z;
    unsigned sum, cnt, mine, sp = 0u;
    for (;;) {
        sum = 0u; cnt = 0u; mine = 0u;
#pragma unroll
        for (unsigned j = 0; j < 16; ++j) { const unsigned c = xb_ld(&bar[XB_XCNT(j)]); sum += c; cnt += (c > 0u) ? 1u : 0u; mine = (j == x) ? c : mine; }
        if (sum == G) break;
        __builtin_amdgcn_s_sleep(1);
        if ((++sp & 255u) == 0u) { if (xb_ld(&bar[XB_TMO])) break; if (sp > XB_SPIN_CAP) { atomicAdd(&bar[XB_TMO], 1u); break; } }
    }
    nloc = mine > 0u ? mine : 1u; nx = cnt > 0u ? cnt : 1u;
}
__device__ __forceinline__ void xcd_barrier(const XcdBarrier& b) {
    asm volatile("s_waitcnt vmcnt(0)" ::: "memory");
    __syncthreads();
    if (threadIdx.x == 0) {
        unsigned* bar = b.bar;
        __builtin_amdgcn_s_waitcnt(0);
        unsigned nloc = b.st[0], nx = b.st[1];
        if (nloc == 0u) { xcd_barrier_complete(bar, b.x, nloc, nx); b.st[0] = nloc; b.st[1] = nx; }
        const unsigned old = xb_add(&bar[XB_XSUB(b.x)], 1u);
        const unsigned gen = old / nloc;
        if (old + 1u == (gen + 1u) * nloc) {
            __builtin_amdgcn_fence(__ATOMIC_RELEASE, "agent");
            asm volatile("s_waitcnt vmcnt(0)" ::: "memory");
            const unsigned og = xb_add(&bar[XB_TOP], 1u);
            const unsigned tg = og / nx;
            if (og + 1u == (tg + 1u) * nx) xb_add(&bar[XB_TOPGEN], 1u);
            else XB_SPIN(xb_ld(&bar[XB_TOPGEN]) == tg, bar);
            __builtin_amdgcn_fence(__ATOMIC_ACQUIRE, "agent");
            xb_add(&bar[XB_XGEN(b.x)], 1u);
            asm volatile("s_waitcnt vmcnt(0)" ::: "memory");
        } else {
            XB_SPIN(xb_ld(&bar[XB_XGEN(b.x)]) == gen, bar);
            __builtin_amdgcn_fence(__ATOMIC_ACQUIRE, "agent");
            asm volatile("s_waitcnt vmcnt(0)" ::: "memory");
        }
    }
    __syncthreads();
}

__device__ __forceinline__ void p0_transpose_item(const float* W, int K, int N, bf16* WT, int row_off, LAS float* scr, int item, int lane, const float* kscale = nullptr) {
    const int nblk = N / 32, kb = item / nblk, nb = item % nblk, k0 = 64 * kb, n0 = 32 * nb;
    { float t[32]; const float* wp = W + (size_t)(k0 + (lane >> 5)) * N + n0 + (lane & 31);
#pragma unroll
      for (int i = 0; i < 32; ++i) t[i] = __builtin_nontemporal_load(&wp[(size_t)(2 * i) * N]);
#pragma unroll
      for (int i = 0; i < 32; ++i) scr[(2 * i + (lane >> 5)) * 33 + (lane & 31)] = kscale ? t[i] * kscale[k0 + 2 * i + (lane >> 5)] : t[i]; }
    LDS_WAIT(); asm volatile("" ::: "memory");
    const int c = lane & 7;
#pragma unroll
    for (int j = 0; j < 4; ++j) { const int n = (lane >> 3) + 8 * j; const LAS float* s = scr + (8 * c) * 33 + n;
        v4u o; o.x = pk2(s[0 * 33], s[1 * 33]); o.y = pk2(s[2 * 33], s[3 * 33]); o.z = pk2(s[4 * 33], s[5 * 33]); o.w = pk2(s[6 * 33], s[7 * 33]);
        *(GAS v4u*)(WT + (size_t)(row_off + n0 + n) * K + k0 + 8 * c) = o; }
    LDS_WAIT(); asm volatile("" ::: "memory");
}
#define PK_CE(a, b) do { const unsigned x_ = (a), y_ = (b); (a) = x_ > y_ ? x_ : y_; (b) = x_ > y_ ? y_ : x_; } while (0)
template <int B> __device__ __forceinline__ void pk_merge16(unsigned (&u)[64]) {
#pragma unroll
    for (int j = 8; j > 0; j >>= 1)
#pragma unroll
        for (int i = 0; i < 16; ++i) { const int l = i ^ j; if (l > i) PK_CE(u[B + i], u[B + l]); }
}
template <int B> __device__ __forceinline__ void pk_sort16(unsigned (&u)[64]) {
#pragma unroll
    for (int k = 2; k <= 16; k <<= 1)
#pragma unroll
        for (int j = k >> 1; j > 0; j >>= 1)
#pragma unroll
            for (int i = 0; i < 16; ++i) { const int l = i ^ j; if (l > i) { if ((i & k) == 0) PK_CE(u[B + i], u[B + l]); else PK_CE(u[B + l], u[B + i]); } }
}
template <int X, int Y> __device__ __forceinline__ void pk_top16(unsigned (&u)[64]) {
#pragma unroll
    for (int i = 0; i < 16; ++i) u[X + i] = u[X + i] > u[Y + 15 - i] ? u[X + i] : u[Y + 15 - i];
    pk_merge16<X>(u);
}
__device__ __forceinline__ void rms_row_to_bf16(const float* xrow, const float* gain, bf16* orow, int lane) {
    const GAS f32x4* xr = (const GAS f32x4*)xrow + lane; const GAS f32x4* gr = (const GAS f32x4*)gain + lane;
    f32x4 v[16]; float s = 0.f;
#pragma unroll
    for (int j = 0; j < 16; ++j) { v[j] = xr[64 * j]; s += (v[j].x * v[j].x + v[j].y * v[j].y) + (v[j].z * v[j].z + v[j].w * v[j].w); }
    const float r = 1.f / sqrtf(wave_sum(s) * (1.f / DM) + EPS);
    GAS v2u* o8 = (GAS v2u*)orow + lane;
#pragma unroll
    for (int j = 0; j < 16; ++j) { const f32x4 g = gr[64 * j]; v2u w; w.x = pk2(v[j].x * r * g.x, v[j].y * r * g.y); w.y = pk2(v[j].z * r * g.z, v[j].w * r * g.w); o8[64 * j] = w; }
}
__device__ __forceinline__ float wave_max(float v) {
#pragma unroll
    for (int o = 1; o < 64; o <<= 1) v = fmaxf(v, __shfl_xor(v, o));
    return v;
}
__device__ __forceinline__ unsigned q8x4(f32x4 v, float inv) {
    const int a = (int)__builtin_rintf(v.x * inv), b = (int)__builtin_rintf(v.y * inv), c = (int)__builtin_rintf(v.z * inv), d = (int)__builtin_rintf(v.w * inv);
    return (unsigned)(a & 255) | ((unsigned)(b & 255) << 8) | ((unsigned)(c & 255) << 16) | ((unsigned)d << 24);
}
__device__ __forceinline__ void rms_row_quant(const float* xrow, const float* gain, const float* kscale, signed char* o8, float* scale_out, bf16* obf, int lane) {
    const GAS f32x4* xr = (const GAS f32x4*)xrow + lane; const GAS f32x4* gr = (const GAS f32x4*)gain + lane; const GAS f32x4* kr = (const GAS f32x4*)kscale + lane;
    f32x4 v[16]; float s = 0.f;
#pragma unroll
    for (int j = 0; j < 16; ++j) { v[j] = __builtin_nontemporal_load(&xr[64 * j]); s += (v[j].x * v[j].x + v[j].y * v[j].y) + (v[j].z * v[j].z + v[j].w * v[j].w); }
    const float r = 1.f / sqrtf(wave_sum(s) * (1.f / DM) + EPS); float am = 0.f;
#pragma unroll
    for (int j = 0; j < 16; ++j) { f32x4 g = gr[64 * j]; if (kscale) g = g * kr[64 * j]; v[j] = v[j] * r * g; am = fmaxf(am, fmaxf(fmaxf(fabsf(v[j].x), fabsf(v[j].y)), fmaxf(fabsf(v[j].z), fabsf(v[j].w)))); }
    am = fmaxf(wave_max(am), 1e-30f); const float inv = 127.f / am;
    if (lane == 0) *scale_out = am * (1.f / 127.f);
    GAS unsigned* o4 = (GAS unsigned*)o8 + lane;
#pragma unroll
    for (int j = 0; j < 16; ++j) o4[64 * j] = q8x4(v[j], inv);
    if (obf) { GAS v2u* ob = (GAS v2u*)obf + lane;
#pragma unroll
        for (int j = 0; j < 16; ++j) { v2u w; w.x = pk2(v[j].x, v[j].y); w.y = pk2(v[j].z, v[j].w); ob[64 * j] = w; } }
}
template <bool NTS = false> __device__ __forceinline__ void row_quant(const float* xrow, signed char* o8, float* scale_out, int lane) {
    const GAS f32x4* xr = (const GAS f32x4*)xrow + lane; f32x4 v[16]; float am = 0.f;
#pragma unroll
    for (int j = 0; j < 16; ++j) { v[j] = __builtin_nontemporal_load(&xr[64 * j]); am = fmaxf(am, fmaxf(fmaxf(fabsf(v[j].x), fabsf(v[j].y)), fmaxf(fabsf(v[j].z), fabsf(v[j].w)))); }
    am = fmaxf(wave_max(am), 1e-30f); const float inv = 127.f / am;
    if (lane == 0) *scale_out = am * (1.f / 127.f);
    GAS unsigned* o4 = (GAS unsigned*)o8 + lane;
#pragma unroll
    for (int j = 0; j < 16; ++j) { if constexpr (NTS) __builtin_nontemporal_store(q8x4(v[j], inv), &o4[64 * j]); else o4[64 * j] = q8x4(v[j], inv); }
}
__device__ __forceinline__ void rms_row_quant_h16(const bf16* hrow, const float* gain, signed char* o8, float* scale_out, float* rinv_out, int lane) {
    const GAS v4u* hr = (const GAS v4u*)hrow + lane; const GAS f32x4* gr = (const GAS f32x4*)gain + 2 * lane;
    float v[8][8]; float s = 0.f;
#pragma unroll
    for (int j = 0; j < 8; ++j) { const v4u w = hr[64 * j]; v[j][0] = bflo(w.x); v[j][1] = bfhi(w.x); v[j][2] = bflo(w.y); v[j][3] = bfhi(w.y); v[j][4] = bflo(w.z); v[j][5] = bfhi(w.z); v[j][6] = bflo(w.w); v[j][7] = bfhi(w.w);
#pragma unroll
        for (int e = 0; e < 8; ++e) s += v[j][e] * v[j][e]; }
    const float r = 1.f / sqrtf(wave_sum(s) * (1.f / DM) + EPS); float am = 0.f;
#pragma unroll
    for (int j = 0; j < 8; ++j) { const f32x4 ga = gr[128 * j], gb = gr[128 * j + 1]; const float gg[8] = {ga.x, ga.y, ga.z, ga.w, gb.x, gb.y, gb.z, gb.w};
#pragma unroll
        for (int e = 0; e < 8; ++e) { v[j][e] = v[j][e] * r * gg[e]; am = fmaxf(am, fabsf(v[j][e])); } }
    am = fmaxf(wave_max(am), 1e-30f); const float inv = 127.f / am;
    if (lane == 0) { *scale_out = am * (1.f / 127.f); *rinv_out = r; }
    GAS v2u* o2 = (GAS v2u*)o8 + lane;
#pragma unroll
    for (int j = 0; j < 8; ++j) { v2u o; o.x = q8x4((f32x4){v[j][0], v[j][1], v[j][2], v[j][3]}, inv); o.y = q8x4((f32x4){v[j][4], v[j][5], v[j][6], v[j][7]}, inv); o2[64 * j] = o; }
}
template <int NCH> __device__ __forceinline__ void row_quant_bf16(const bf16* src, const float* kscale, signed char* o8, float* scale_out, int lane) {
    const GAS v4u* sr = (const GAS v4u*)src + lane; const GAS f32x4* kr = (const GAS f32x4*)kscale + 2 * lane; float v[NCH][8]; float am = 0.f;
#pragma unroll
    for (int j = 0; j < NCH; ++j) { const v4u w = sr[64 * j]; const f32x4 ka = kr[128 * j], kb = kr[128 * j + 1];
        v[j][0] = bflo(w.x) * ka.x; v[j][1] = bfhi(w.x) * ka.y; v[j][2] = bflo(w.y) * ka.z; v[j][3] = bfhi(w.y) * ka.w; v[j][4] = bflo(w.z) * kb.x; v[j][5] = bfhi(w.z) * kb.y; v[j][6] = bflo(w.w) * kb.z; v[j][7] = bfhi(w.w) * kb.w;
#pragma unroll
        for (int e = 0; e < 8; ++e) am = fmaxf(am, fabsf(v[j][e])); }
    am = fmaxf(wave_max(am), 1e-30f); const float inv = 127.f / am;
    if (lane == 0) *scale_out = am * (1.f / 127.f);
    GAS v2u* o2 = (GAS v2u*)o8 + lane;
#pragma unroll
    for (int j = 0; j < NCH; ++j) { v2u o; o.x = q8x4((f32x4){v[j][0], v[j][1], v[j][2], v[j][3]}, inv); o.y = q8x4((f32x4){v[j][4], v[j][5], v[j][6], v[j][7]}, inv); o2[64 * j] = o; }
}
__device__ __forceinline__ void premix_quant_run8(const bf16* zp, int row0, signed char* o8, float* scale_out, int lane) {
    const int t0 = row0 & (SEQ - 1);
    const bf16* base = zp + (size_t)row0 * 2048 + lane * 8;
    float sum[4][8];
#pragma unroll
    for (int j = 0; j < 4; ++j) {
#pragma unroll
        for (int e = 0; e < 8; ++e) sum[j][e] = 0.f;
        const int w = 2 << j, n = t0 < w ? t0 : w;
#pragma unroll 1
        for (int k = 1; k <= n; ++k) { const v4u v = *(const GAS v4u*)(base - (size_t)k * 2048 + 512 * j);
            sum[j][0] += bflo(v.x); sum[j][1] += bfhi(v.x); sum[j][2] += bflo(v.y); sum[j][3] += bfhi(v.y); sum[j][4] += bflo(v.z); sum[j][5] += bfhi(v.z); sum[j][6] += bflo(v.w); sum[j][7] += bfhi(v.w); } }
#pragma unroll 1
    for (int i = 0; i < 8; ++i) { const int t = t0 + i; const bf16* rp = base + (size_t)i * 2048;
        float out[4][8]; float am = 0.f;
#pragma unroll
        for (int j = 0; j < 4; ++j) { const int w = 2 << j; const v4u v = *(const GAS v4u*)(rp + 512 * j);
            const float cur[8] = {bflo(v.x), bfhi(v.x), bflo(v.y), bfhi(v.y), bflo(v.z), bfhi(v.z), bflo(v.w), bfhi(v.w)};
#pragma unroll
            for (int e = 0; e < 8; ++e) sum[j][e] += cur[e];
            if (t - w >= 0) { const v4u o = *(const GAS v4u*)(rp - (size_t)w * 2048 + 512 * j);
                sum[j][0] -= bflo(o.x); sum[j][1] -= bfhi(o.x); sum[j][2] -= bflo(o.y); sum[j][3] -= bfhi(o.y); sum[j][4] -= bflo(o.z); sum[j][5] -= bfhi(o.z); sum[j][6] -= bflo(o.w); sum[j][7] -= bfhi(o.w); }
            const float rc = 1.f / (float)(t + 1 < w ? t + 1 : w);
#pragma unroll
            for (int e = 0; e < 8; ++e) { out[j][e] = sum[j][e] * rc - cur[e]; am = fmaxf(am, fabsf(out[j][e])); } }
        am = fmaxf(wave_max(am), 1e-30f); const float inv = 127.f / am;
        if (lane == 0) scale_out[i] = am * (1.f / 127.f);
        GAS v2u* o2 = (GAS v2u*)(o8 + (size_t)i * 2048) + lane;
#pragma unroll
        for (int j = 0; j < 4; ++j) { v2u o; o.x = q8x4((f32x4){out[j][0], out[j][1], out[j][2], out[j][3]}, inv); o.y = q8x4((f32x4){out[j][4], out[j][5], out[j][6], out[j][7]}, inv); o2[64 * j] = o; } }
}
__device__ __forceinline__ void row_quant_wg(const f32x4 (&v)[8], signed char* o8, float* scale_out, LAS float* red, int tid, int lane, int wave) {
    float am = 0.f;
#pragma unroll
    for (int j = 0; j < 8; ++j) am = fmaxf(am, fmaxf(fmaxf(fabsf(v[j].x), fabsf(v[j].y)), fmaxf(fabsf(v[j].z), fabsf(v[j].w))));
    am = wave_max(am);
    if (lane == 0) red[wave] = am;
    LDS_WAIT(); __syncthreads();
    am = fmaxf(fmaxf(fmaxf(red[0], red[1]), fmaxf(red[2], red[3])), fmaxf(fmaxf(red[4], red[5]), fmaxf(red[6], red[7])));
    am = fmaxf(am, 1e-30f); const float inv = 127.f / am;
    if (tid == 0) *scale_out = am * (1.f / 127.f);
    GAS unsigned* o4 = (GAS unsigned*)o8 + tid;
#pragma unroll
    for (int j = 0; j < 8; ++j) o4[512 * j] = q8x4(v[j], inv);
    __syncthreads();
}
template <bool NTS = false> __device__ __forceinline__ void tr8_item(const signed char* W8, int K, int N, signed char* WT, LAS unsigned* scr, int item, int lane) {
    const int nblk = N / 128, kb = item / nblk, nb = item % nblk, k0 = 128 * kb, n0 = 128 * nb, nq = lane & 31, kh = lane >> 5;
    unsigned r[64]; const signed char* src = W8 + (size_t)(k0 + 64 * kh) * N + n0 + 4 * nq;
#pragma unroll
    for (int i = 0; i < 64; ++i) r[i] = __builtin_nontemporal_load((const GAS unsigned*)(src + (size_t)i * N));
#pragma unroll
    for (int g = 0; g < 16; ++g)
#pragma unroll
        for (int c = 0; c < 4; ++c)
            scr[(4 * nq + c) * 33 + 16 * kh + g] = ((r[4 * g] >> (8 * c)) & 255u) | (((r[4 * g + 1] >> (8 * c)) & 255u) << 8) | (((r[4 * g + 2] >> (8 * c)) & 255u) << 16) | (((r[4 * g + 3] >> (8 * c)) & 255u) << 24);
    LDS_WAIT(); asm volatile("" ::: "memory");
    const int ch = lane & 7;
#pragma unroll
    for (int j = 0; j < 16; ++j) { const int n = (lane >> 3) + 8 * j; const LAS unsigned* sp = scr + n * 33 + 4 * ch;
        v4u o; o.x = sp[0]; o.y = sp[1]; o.z = sp[2]; o.w = sp[3];
        if constexpr (NTS) __builtin_nontemporal_store(o, (GAS v4u*)(WT + (size_t)(n0 + n) * K + k0 + 16 * ch)); else *(GAS v4u*)(WT + (size_t)(n0 + n) * K + k0 + 16 * ch) = o; }
    LDS_WAIT(); asm volatile("" ::: "memory");
}
__device__ __forceinline__ void sincos_red(float angf, float& sn, float& cs) {
    const double a = (double)angf;
    const double kd = __builtin_rint(a * 0.63661977236758134308);
    const double r = __builtin_fma(-kd, 1.57079632679489661923, a);
    const int q = (int)kd & 3;
    const double r2 = r * r;
    const double sp = r * (1.0 + r2 * (-1.0 / 6 + r2 * (1.0 / 120 + r2 * (-1.0 / 5040 + r2 * (1.0 / 362880 + r2 * (-1.0 / 39916800))))));
    const double cp = 1.0 + r2 * (-0.5 + r2 * (1.0 / 24 + r2 * (-1.0 / 720 + r2 * (1.0 / 40320 + r2 * (-1.0 / 3628800 + r2 * (1.0 / 479001600))))));
    const double s4 = (q & 1) ? cp : sp, c4 = (q & 1) ? sp : cp;
    sn = (float)((q & 2) ? -s4 : s4); cs = (float)(((q + 1) & 2) ? -c4 : c4);
}
__device__ __forceinline__ void wave_argmax(float& v, int& i) {
#pragma unroll
    for (int o = 1; o < 64; o <<= 1) { const float ov = __shfl_xor(v, o); const int oi = __shfl_xor(i, o); const bool take = (ov > v) || (ov == v && oi < i); v = take ? ov : v; i = take ? oi : i; }
}

struct Args { const float* in[15]; float* out; unsigned char* ws; int ph_lo, ph_hi; };
__global__ void __launch_bounds__(NWAVES * 64, 2) fwd_kernel(Args args) {
    extern __shared__ __attribute__((aligned(16))) unsigned char lds_raw[];
    LAS unsigned char* lds = (LAS unsigned char*)lds_raw;
    volatile LAS unsigned* MISC = (volatile LAS unsigned*)(lds + MISC_OFF);
    const int G = gridDim.x;
    const int vcu = (G % 8 == 0) ? ((int)blockIdx.x % 8) * (G / 8) + (int)blockIdx.x / 8 : (int)blockIdx.x;
#define PH_BEGIN \
    int tid = threadIdx.x; asm volatile("" : "+v"(tid)); \
    const int lane = tid & 63, wave = __builtin_amdgcn_readfirstlane(tid >> 6); \
    const int gw = vcu * NWAVES + wave, NGW = G * NWAVES; const int gt = vcu * (NWAVES * 64) + tid, NGT = G * NWAVES * 64; \
    unsigned char* ws = args.ws; \
    const float* x = args.in[0]; const float* norm_mix = args.in[1]; const float* w_in = args.in[2]; const float* pool_w = args.in[3]; const float* pool_scale = args.in[4]; \
    const float* q_norm = args.in[5]; const float* k_norm = args.in[6]; const float* w_pool_out = args.in[7]; const float* w_attn_out = args.in[8]; const float* w_o = args.in[9]; \
    const float* norm_ffn = args.in[10]; const float* peer_wq = args.in[11]; const float* peer_sub = args.in[12]; const float* peer_u = args.in[13]; const float* peer_v = args.in[14]; \
    float* out = args.out; \
    float* rope_cos = (float*)(ws + WS_ROPE); float* rope_sin = rope_cos + SEQ * 64; \
    float* kmean = (float*)(ws + WS_KMEAN); \
    unsigned* selbuf = (unsigned*)(ws + WS_SEL); \
    int* pidx = (int*)(ws + WS_PIDX); float* pgate = (float*)(ws + WS_PG); \
    bf16* poolwT = (bf16*)(ws + WS_POOLW); signed char* wpo8 = (signed char*)(ws + WS_WPO); signed char* wao8 = (signed char*)(ws + WS_WAO); signed char* wo8 = (signed char*)(ws + WS_WO); bf16* wqT = (bf16*)(ws + WS_WQ); \
    signed char* yp8 = (signed char*)(ws + WS_YP8); signed char* ya8 = (signed char*)(ws + WS_YA8); signed char* mrg8 = (signed char*)(ws + WS_YPRE); \
    signed char* u8 = (signed char*)(ws + WS_U8); signed char* vT8 = (signed char*)(ws + WS_VT8); signed char* win8 = (signed char*)(ws + WS_WIN8); signed char* xn8 = (signed char*)(ws + WS_XN8); \
    signed char* hn8 = (signed char*)(ws + WS_WIN8); signed char* act8 = (signed char*)(ws + WS_ACT8); \
    float* sa_x = (float*)(ws + WS_SCALE); float* sa_hn = sa_x + T; float* sa_act = sa_hn + T; float* sb_win = sa_act + T; float* sb_u = sb_win + INW; float* sb_v = sb_u + PEER_E; \
    float* sb_wo = sb_v + DM; float* sb_wpo = sb_wo + DM; float* sb_wao = sb_wpo + DM; float* sa_yp = sb_wao + DM; float* sa_ya = sa_yp + T; float* sa_m = sa_ya + T; \
    float* sk_win = sa_m + T; float* sk_v = sk_win + DM; float* sk_wo = sk_v + PEER_E; float* sk_wpo = sk_wo + DM; float* sk_wao = sk_wpo + PW; float* rinv_h = sk_wao + PW; float* sb_wq = rinv_h + T; signed char* wq8 = (signed char*)(ws + WS_WPO);   \
    signed char* win8r = (signed char*)(ws + WS_Z); signed char* v8r = win8r + (size_t)64 * MiB; signed char* wo8r = v8r + (size_t)64 * MiB; signed char* wpo8r = wo8r + (size_t)16 * MiB; signed char* wao8r = wpo8r + (size_t)8 * MiB; \
    unsigned* cmax_win = (unsigned*)(ws + WS_CTL + CTL_CMAX_WIN); unsigned* cmax_v = (unsigned*)(ws + WS_CTL + CTL_CMAX_V); \
    unsigned* cmax_wo = (unsigned*)(ws + WS_CTL + CTL_CMAX_WO); unsigned* cmax_wpo = (unsigned*)(ws + WS_CTL + CTL_CMAX_WPO); unsigned* cmax_wao = (unsigned*)(ws + WS_CTL + CTL_CMAX_WAO); \
    bf16* ypre = (bf16*)(ws + WS_YPRE); bf16* hn = (bf16*)(ws + WS_XN8); \
    bf16* mrg = (bf16*)(ws + WS_MRG); float* pq = (float*)(ws + WS_MRG); \
    bf16* Z = (bf16*)(ws + WS_Z); bf16* act = (bf16*)(ws + WS_Z); bf16* h16 = (bf16*)(ws + WS_H16); \
    bf16* wpoST = (bf16*)(ws + WS_WPO); bf16* poolw16 = (bf16*)(ws + WS_POOLW); bf16* wcombT = (bf16*)(ws + WS_MRG); signed char* wcomb8 = (signed char*)(ws + WS_WAO) + (size_t)8 * MiB; \
    (void)wpoST; (void)poolw16; (void)wcombT; (void)wcomb8; \
    bf16* zp = Z; bf16* zq = Z + ZSLOT; bf16* zk = Z + 2 * ZSLOT; bf16* zv = Z + 3 * ZSLOT; bf16* ypool = Z; \
    (void)lane; (void)wave; (void)gw; (void)NGW; (void)gt; (void)NGT; (void)x; (void)norm_mix; (void)w_in; (void)pool_w; (void)pool_scale; (void)q_norm; (void)k_norm; (void)w_pool_out; \
    (void)w_attn_out; (void)w_o; (void)norm_ffn; (void)peer_wq; (void)peer_sub; (void)peer_u; (void)peer_v; (void)out; (void)rope_cos; (void)rope_sin; (void)kmean; (void)selbuf; (void)pidx; \
    (void)pgate; (void)poolwT; (void)wpo8; (void)wao8; (void)wo8; (void)wqT; (void)yp8; (void)ya8; (void)mrg8; (void)sb_wo; (void)sb_wpo; (void)sb_wao; (void)sa_yp; (void)sa_ya; (void)sa_m; (void)cmax_wo; (void)cmax_wpo; (void)cmax_wao; (void)u8; (void)vT8; (void)win8; (void)xn8; (void)hn8; (void)act8; (void)sa_x; (void)sa_hn; (void)sa_act; (void)sb_win; (void)sb_u; (void)sb_v; \
    (void)rinv_h; (void)sb_wq; (void)wq8; (void)h16; (void)sk_win; (void)sk_v; (void)sk_wo; (void)sk_wpo; (void)sk_wao; (void)win8r; (void)v8r; (void)wo8r; (void)wpo8r; (void)wao8r; (void)cmax_win; (void)cmax_v; (void)ypre; (void)hn; (void)mrg; (void)pq; (void)act; (void)zp; (void)zq; (void)zk; (void)zv; (void)ypool
    gu32* ctl = (gu32*)(args.ws + WS_CTL);
    for (int u = threadIdx.x; u < (LDS_BYTES - LDSCTL_OFF) / 4; u += NWAVES * 64) ((LAS unsigned*)(lds + LDSCTL_OFF))[u] = 0u;
    __syncthreads();
    XcdBarrier bar; bar.bar = (unsigned*)(ctl + CW_BAR); bar.x = 0; bar.st = nullptr;
    if (MK_N_LAUNCHES == 1) bar = xcd_barrier_post((unsigned*)(ctl + CW_BAR), MISC + 8);
    const int lo = args.ph_lo, hi = args.ph_hi;
#ifndef PH_EN
#define PH_EN 0xffffffffu
#endif
#define IN(k) (((PH_EN >> (k)) & 1u) && lo <= (k) && (k) < hi)
#define GRID_BAR(k) do { if (IN(k) && IN((k) + 1)) xcd_barrier(bar); } while (0)

    for (int rep0 = 0; rep0 < (((PH_REP >> 0) & 1u) ? 2 : 1); ++rep0)
    if (IN(0)) { PH_BEGIN;
        LAS float* scr = (LAS float*)(lds + wave * 16384);
        { LAS float* red = (LAS float*)(lds + 131072);
          f32x4 cv[8], nv[8];
          if (vcu < DM) {
#pragma unroll
              for (int j = 0; j < 8; ++j) nv[j] = __builtin_nontemporal_load((const GAS f32x4*)(w_in + (size_t)vcu * INW) + tid + 512 * j); }
          for (int k = vcu; k < DM; k += G) {
#pragma unroll
              for (int j = 0; j < 8; ++j) cv[j] = nv[j];
              if (k + G < DM) {
#pragma unroll
                  for (int j = 0; j < 8; ++j) nv[j] = __builtin_nontemporal_load((const GAS f32x4*)(w_in + (size_t)(k + G) * INW) + tid + 512 * j); }
              row_quant_wg(cv, win8r + (size_t)k * INW, sk_win + k, red, tid, lane, wave); } }
        for (int r = gw; r < PEER_E + DM + PW + AW; r += NGW) {
            if (r < PEER_E) row_quant(peer_v + (size_t)r * DM, v8r + (size_t)r * DM, sk_v + r, lane);
            else if (r < PEER_E + DM) { const int k = r - PEER_E; row_quant(w_o + (size_t)k * DM, wo8r + (size_t)k * DM, sk_wo + k, lane); }
            else if (r < PEER_E + DM + PW) { }
            else { const int k = r - PEER_E - DM - PW; row_quant(w_attn_out + (size_t)k * DM, wao8r + (size_t)k * DM, sk_wao + k, lane); } }
        constexpr int I_WQ = (DM / 64) * (2048 / 32), I_POT = (PW / 64) * (DM / 32);
        for (int it = gw; it < I_WQ + I_POT; it += NGW) {
            if (it < I_WQ) p0_transpose_item(peer_wq, DM, 2048, wqT, 0, scr, it, lane);
            else p0_transpose_item(w_pool_out, PW, DM, wpoST, 0, scr, it - I_WQ, lane, pool_scale);
        }
        for (int i = gt; i < 4 * 512 * 512 / 8; i += NGT) {
            const GAS f32x4* sp = (const GAS f32x4*)pool_w + 2 * i; const f32x4 a = sp[0], b = sp[1];
            v4u o; o.x = pk2(a.x, a.y); o.y = pk2(a.z, a.w); o.z = pk2(b.x, b.y); o.w = pk2(b.z, b.w); *((GAS v4u*)poolw16 + i) = o; }
        for (int e = gw; e < PEER_E; e += NGW) row_quant<true>(peer_u + (size_t)e * DM, u8 + (size_t)e * DM, sb_u + e, lane);
        for (int i = gt; i < SEQ * 64; i += NGT) { const int pos = i >> 6, j = i & 63;
            const float inv = (float)exp(-(double)j * (1.0 / 64.0) * 9.210340371976184);
            const float ang = (float)pos * inv; float sn, cs; sincos_red(ang, sn, cs); rope_cos[i] = cs; rope_sin[i] = sn; }
        for (int i = gt; i < INW + 3 * DM; i += NGT) { float* sb = i < INW ? sb_win + i : i < INW + DM ? sb_v + (i - INW) : i < INW + 2 * DM ? sb_wo + (i - INW - DM) : sb_wao + (i - INW - 2 * DM);
            *sb = 1.f; }
    }
    GRID_BAR(0);

    for (int rep1 = 0; rep1 < (((PH_REP >> 1) & 1u) ? 2 : 1); ++rep1)
    if (IN(1)) { PH_BEGIN;
        LAS unsigned* scr = (LAS unsigned*)(lds + wave * 16896);
        constexpr int I_WIN = (DM / 128) * (INW / 128), I_V = (PEER_E / 128) * (DM / 128), I_O = (DM / 128) * (DM / 128), I_PO = (PW / 128) * (DM / 128);
        for (int it = gw; it < I_WIN + I_V + I_O + I_PO; it += NGW) { int r = it;
            if (r < I_WIN) { tr8_item(win8r, DM, INW, win8, scr, r, lane); continue; } r -= I_WIN;
            if (r < I_V) { tr8_item<true>(v8r, PEER_E, DM, vT8, scr, r, lane); continue; } r -= I_V;
            if (r < I_O) { tr8_item(wo8r, DM, DM, wo8, scr, r, lane); continue; } r -= I_O;
            tr8_item(wao8r, AW, DM, wao8, scr, r, lane); }
        for (int m = gw; m < T; m += NGW) rms_row_quant(x + (size_t)m * DM, norm_mix, sk_win, xn8 + (size_t)m * DM, sa_x + m, nullptr, lane);
        __syncthreads();
        {
            pg8::Gemm g{wpoST, poolw16, 512 * 2, 2048 * 2, 512 * 2}; pg8::PoolOrder S; S.init(DM, PW, G, (int)blockIdx.x);
            pg8::EpiBf16 E{wcombT, 2048};
            pg8::gemm_phase<pg8::EpiBf16, pg8::PoolOrder, true>(lds, g, S, E);
        }
    }
    GRID_BAR(1);

    for (int rep2 = 0; rep2 < (((PH_REP >> 2) & 1u) ? 2 : 1); ++rep2)
    if (IN(2)) { PH_BEGIN;
        pg8::Gemm g{xn8, win8, DM, DM, DM}; pg8::StaticOrder S; S.init(T, INW, G, (int)blockIdx.x);
        pg8::EpiZ8 E{Z, sa_x, sb_win};
        pg8::gemm_phase<pg8::EpiZ8, pg8::StaticOrder, PG8_ALIGN>(lds, g, S, E);
    }
    GRID_BAR(2);

    if (IN(3)) { PH_BEGIN;
        for (int n = gw; n < DM; n += NGW) row_quant_bf16<4>(wcombT + (size_t)n * 2048, sb_win  , wcomb8 + (size_t)n * 2048, sb_wpo + n, lane);
        for (int n = gw; n < 2048; n += NGW) row_quant_bf16<8>(wqT + (size_t)n * DM, sb_win  , wq8 + (size_t)n * DM, sb_wq + n, lane);
        LAS float* red = (LAS float*)lds;
        const int sub = tid & 15, rgrp = tid >> 4;
        for (int un = vcu; un < BATCH * NBLK * NH; un += G) {
            const int which = 1, h = un & 15, blk = (un >> 4) & 15, b = un >> 8;
            bf16* base = (which ? zk : zq) + ((size_t)(b * SEQ + blk * MOBA_L)) * 2048 + h * HD + sub * 8;
            const float* gn = (which ? k_norm : q_norm) + sub * 8;
            float gv[8];
#pragma unroll
            for (int e = 0; e < 8; ++e) gv[e] = gn[e];
            float cs8[8];
#pragma unroll
            for (int e = 0; e < 8; ++e) cs8[e] = 0.f;
            for (int p = 0; p < 8; ++p) {
                const int i = rgrp + 32 * p, pos = blk * MOBA_L + i;
                const v4u v = *(const GAS v4u*)(base + (size_t)i * 2048);
                float f[8] = {bflo(v.x), bfhi(v.x), bflo(v.y), bfhi(v.y), bflo(v.z), bfhi(v.z), bflo(v.w), bfhi(v.w)};
                float ss = 0.f;
#pragma unroll
                for (int e = 0; e < 8; ++e) ss += f[e] * f[e];
                ss += __shfl_xor(ss, 1); ss += __shfl_xor(ss, 2); ss += __shfl_xor(ss, 4); ss += __shfl_xor(ss, 8);
                const float r = 1.f / sqrtf(ss * (1.f / HD) + EPS);
                const f32x4 c0 = *(const GAS f32x4*)(rope_cos + pos * 64 + (sub & 7) * 8), c1 = *(const GAS f32x4*)(rope_cos + pos * 64 + (sub & 7) * 8 + 4);
                const f32x4 s0 = *(const GAS f32x4*)(rope_sin + pos * 64 + (sub & 7) * 8), s1 = *(const GAS f32x4*)(rope_sin + pos * 64 + (sub & 7) * 8 + 4);
                const float cc[8] = {c0.x, c0.y, c0.z, c0.w, c1.x, c1.y, c1.z, c1.w}, sn[8] = {s0.x, s0.y, s0.z, s0.w, s1.x, s1.y, s1.z, s1.w};
                float o[8];
#pragma unroll
                for (int e = 0; e < 8; ++e) { const float a = f[e] * r * gv[e]; const float pa = __shfl_xor(a, 8);
                    o[e] = (sub < 8) ? a * cc[e] - pa * sn[e] : a * cc[e] + pa * sn[e]; cs8[e] += o[e]; }
                v4u ov; ov.x = pk2(o[0], o[1]); ov.y = pk2(o[2], o[3]); ov.z = pk2(o[4], o[5]); ov.w = pk2(o[6], o[7]);
                *(GAS v4u*)(base + (size_t)i * 2048) = ov;
            }
            if (which) {
#pragma unroll
                for (int e = 0; e < 8; ++e) { cs8[e] += __shfl_xor(cs8[e], 16); cs8[e] += __shfl_xor(cs8[e], 32); }
                if (lane < 16) {
#pragma unroll
                    for (int e = 0; e < 8; ++e) red[wave * 128 + sub * 8 + e] = cs8[e]; }
                LDS_WAIT(); __syncthreads();
                if (tid < 128) { float s = 0.f;
#pragma unroll
                    for (int wv = 0; wv < 8; ++wv) s += red[wv * 128 + tid];
                    kmean[((size_t)(b * NH + h) * NBLK + blk) * HD + tid] = s * (1.f / MOBA_L); }
                __syncthreads();
            }
        }
    }
    GRID_BAR(3);


    if (IN(5)) { PH_BEGIN;
        {
            const int total = BATCH * NH * 8;
            int L = (int)blockIdx.x;
            if (L < total) {
                const att::Bases AB{zq, zk, zv, kmean, q_norm, rope_cos, rope_sin};
                auto mkref = [&](int Lx, int pass) { const int xcd = Lx & 7, j = Lx >> 3, bh = xcd * 8 + (j >> 3), xx = j & 7, qb = pass ? 15 - xx : xx;
                    att::BlockRef r; r.tok0 = (bh >> 4) * SEQ; r.h = bh & 15; r.P0 = qb * MOBA_L; return r; };
                int pass = 0; att::BlockRef cur = mkref(L, 0);
                att::Seam S;
                att::moba_prime(AB, cur, (char*)lds_raw, S);
                for (;;) {
                    const bool more_pass = pass == 0, more_item = L + G < total, last = !more_pass && !more_item;
                    int passn = pass + 1, Ln = L;
                    if (!more_pass) { passn = 0; Ln = more_item ? L + G : L; }
                    const att::BlockRef nxt = last ? cur : mkref(Ln, passn);
                    att::moba_block(AB, cur, nxt, (char*)lds_raw, S);
                    if (last) break;
                    cur = nxt; pass = passn; L = Ln;
                }
            }
            __syncthreads();
        }
    }
    GRID_BAR(5);

    for (int rep6 = 0; rep6 < (((PH_REP >> 6) & 1u) ? 2 : 1); ++rep6)
    if (IN(6)) { PH_BEGIN;
        for (int r8 = gw; r8 < T / 8; r8 += NGW) premix_quant_run8(zp, 8 * r8, yp8 + (size_t)(8 * r8) * 2048, sa_yp + 8 * r8, lane);
        for (int m = gw; m < T; m += NGW) row_quant_bf16<4>(zq + (size_t)m * 2048, sk_wao, ya8 + (size_t)m * 2048, sa_ya + m, lane);
    }
    GRID_BAR(6);

    for (int rep7 = 0; rep7 < (((PH_REP >> 7) & 1u) ? 2 : 1); ++rep7)
    if (IN(7)) { PH_BEGIN;
        { pg8::Gemm g{yp8, wcomb8, PW, PW, PW}; pg8::StaticOrder S; S.init(T, DM, G, (int)blockIdx.x);
          pg8::EpiGate8<false> E{mrg, Z + 4 * ZSLOT, sa_yp, sb_wpo};
          pg8::gemm_phase<pg8::EpiGate8<false>, pg8::StaticOrder, true>(lds, g, S, E); }
#ifndef PROBE_NO_ATTN
#define PROBE_NO_ATTN 0
#endif
        if (!PROBE_NO_ATTN) { pg8::Gemm g{ya8, wao8, AW, AW, AW}; pg8::StaticOrder S; S.init(T, DM, G, (int)blockIdx.x);
          pg8::EpiGate8<true> E{mrg, Z + 6 * ZSLOT, sa_ya, sb_wao};
          pg8::gemm_phase<pg8::EpiGate8<true>, pg8::StaticOrder, true>(lds, g, S, E); }
    }
    GRID_BAR(7);

    for (int rep8 = 0; rep8 < (((PH_REP >> 8) & 1u) ? 2 : 1); ++rep8)
    if (IN(8)) { PH_BEGIN; for (int m = gw; m < T; m += NGW) row_quant_bf16<8>(mrg + (size_t)m * DM, sk_wo, mrg8 + (size_t)m * DM, sa_m + m, lane); }
    GRID_BAR(8);

    for (int rep9 = 0; rep9 < (((PH_REP >> 9) & 1u) ? 2 : 1); ++rep9)
    if (IN(9)) { PH_BEGIN;
        pg8::Gemm g{mrg8, wo8, DM, DM, DM}; pg8::StaticOrder S; S.init(T, DM, G, (int)blockIdx.x);
        pg8::EpiH16_8 E{h16, DM, x, sa_m, sb_wo};
        pg8::gemm_phase<pg8::EpiH16_8, pg8::StaticOrder, true>(lds, g, S, E);
    }
    GRID_BAR(9);

    for (int rep10 = 0; rep10 < (((PH_REP >> 10) & 1u) ? 2 : 1); ++rep10)
    if (IN(10)) { PH_BEGIN; for (int m = gw; m < T; m += NGW) rms_row_quant_h16(h16 + (size_t)m * DM, norm_ffn, hn8 + (size_t)m * DM, sa_hn + m, rinv_h + m, lane); }
    GRID_BAR(10);

    for (int rep11 = 0; rep11 < (((PH_REP >> 11) & 1u) ? 2 : 1); ++rep11)
    if (IN(11)) { PH_BEGIN;
        pg8::Gemm g{hn8, wq8, DM, DM, DM}; pg8::StaticOrder S; S.init(T, 2048, G, (int)blockIdx.x);
        pg8::EpiBf16_8 E{(bf16*)pq, 2048, sa_hn, sb_wq};
        pg8::gemm_phase<pg8::EpiBf16_8, pg8::StaticOrder, true>(lds, g, S, E);
    }
    if (IN(11) && IN(12)) { __builtin_amdgcn_fence(__ATOMIC_RELEASE, "workgroup"); asm volatile("s_waitcnt vmcnt(0)" ::: "memory"); __syncthreads(); __builtin_amdgcn_fence(__ATOMIC_ACQUIRE, "workgroup"); }

    for (int rep12 = 0; rep12 < (((PH_REP >> 12) & 1u) ? 2 : 1); ++rep12)
    if (IN(12)) { PH_BEGIN;
        LAS bf16* SKh = (LAS bf16*)lds; LAS bf16* SKo = (LAS bf16*)(lds + 34816);
        LAS unsigned* CMPw = (LAS unsigned*)(lds + 69632) + wave * 1152;
        const int tk = lane & 31, hi = lane >> 5;
        auto ordu = [](unsigned u) { return (u & 0x80000000u) ? ~u : (u | 0x80000000u); };
        auto unord = [](unsigned o) { return (o & 0x80000000u) ? (o ^ 0x80000000u) : ~o; };
        auto pswap_sum = [](int c) { const auto rr = __builtin_amdgcn_permlane32_swap((unsigned)c, (unsigned)c, false, false); return (int)(rr[0] + rr[1]); };
        pg8::StaticOrder S11; S11.init(T, 2048, G, (int)blockIdx.x);
        for (int ui = 0; ; ++ui) { pg8::Unit uq; if (!S11.next(ui, uq)) break;
            const int h = uq.pn, tg = uq.pm; const int tok = tg * 256 + wave * 32 + tk;
#pragma unroll 1
            for (int p = 0; p < 2; ++p) {
                __syncthreads();
                { const float* sk = peer_sub + (size_t)(h * 2 + p) * PEER_NK * 128;
                  for (int i = tid; i < PEER_NK * 32; i += NWAVES * 64) { const int n = i >> 5, d4 = i & 31; const f32x4 v = *(const GAS f32x4*)(sk + n * 128 + d4 * 4);
                      const unsigned h0 = f2bf(v.x), h1 = f2bf(v.y), h2 = f2bf(v.z), h3 = f2bf(v.w);
                      const unsigned l0 = f2bf(v.x - __uint_as_float(h0 << 16)), l1 = f2bf(v.y - __uint_as_float(h1 << 16)), l2 = f2bf(v.z - __uint_as_float(h2 << 16)), l3 = f2bf(v.w - __uint_as_float(h3 << 16));
                      *(LAS v2u*)(SKh + n * 136 + d4 * 4) = (v2u){h0 | (h1 << 16), h2 | (h3 << 16)}; *(LAS v2u*)(SKo + n * 136 + d4 * 4) = (v2u){l0 | (l1 << 16), l2 | (l3 << 16)}; } }
                att::bf16x8 bqv[8];
                { const bf16* qp = (const bf16*)pq + (size_t)tok * 2048 + h * 256 + p * 128 + hi * 8;
#pragma unroll
                  for (int s2 = 0; s2 < 8; ++s2) bqv[s2] = *(const GAS att::bf16x8*)(qp + 16 * s2); }
                LDS_WAIT(); __syncthreads();
                att::f32x16 acc[4];
#pragma unroll
                for (int kt = 0; kt < 4; ++kt) acc[kt] = att::f32x16{};
#pragma unroll
                for (int s2 = 0; s2 < 8; ++s2) {
#pragma unroll
                    for (int kt = 0; kt < 4; ++kt) { const int off = (32 * kt + tk) * 136 + 16 * s2 + 8 * hi;
                        const att::bf16x8 ah = *(const LAS att::bf16x8*)(SKh + off), al = *(const LAS att::bf16x8*)(SKo + off);
                        acc[kt] = __builtin_amdgcn_mfma_f32_32x32x16_bf16(ah, bqv[s2], acc[kt], 0, 0, 0); acc[kt] = __builtin_amdgcn_mfma_f32_32x32x16_bf16(al, bqv[s2], acc[kt], 0, 0, 0); } }
                unsigned u[64];
#pragma unroll
                for (int e = 0; e < 64; ++e) { const float f = acc[e >> 4][e & 15]; u[e] = ordu((__float_as_uint(f) & ~127u) | (unsigned)(32 * (e >> 4) + ((e & 15) & 3) + 8 * ((e & 15) >> 2) + 4 * hi)); }
                pk_sort16<0>(u); pk_sort16<16>(u); pk_sort16<32>(u); pk_sort16<48>(u);
                pk_top16<0, 16>(u); pk_top16<32, 48>(u); pk_top16<0, 32>(u);
                { unsigned z[16];
#pragma unroll
                  for (int i = 0; i < 16; ++i) { const auto rr = __builtin_amdgcn_permlane32_swap(u[i], u[i], false, false); const unsigned x0 = rr[0]; z[i] = x0; u[16 + i] = rr[1]; }
#pragma unroll
                  for (int i = 0; i < 16; ++i) u[i] = z[i];
                  pk_top16<0, 16>(u);
                  if (hi == 0) { LAS v4u* dst = (LAS v4u*)(CMPw + tk * 36 + p * 16);
#pragma unroll
                      for (int q = 0; q < 4; ++q) dst[q] = (v4u){unord(u[4 * q]), unord(u[4 * q + 1]), unord(u[4 * q + 2]), unord(u[4 * q + 3])}; } }
            }
            LDS_WAIT(); asm volatile("" ::: "memory");
            float A[16], Bv[16]; unsigned KA[16], KB[16];
            { const LAS v4u* src = (const LAS v4u*)(CMPw + tk * 36);
#pragma unroll
              for (int q = 0; q < 4; ++q) { const v4u w = src[q], x = src[4 + q];
                  A[4 * q] = __uint_as_float(w.x); A[4 * q + 1] = __uint_as_float(w.y); A[4 * q + 2] = __uint_as_float(w.z); A[4 * q + 3] = __uint_as_float(w.w);
                  KA[4 * q] = w.x & 127u; KA[4 * q + 1] = w.y & 127u; KA[4 * q + 2] = w.z & 127u; KA[4 * q + 3] = w.w & 127u;
                  Bv[4 * q] = __uint_as_float(x.x); Bv[4 * q + 1] = __uint_as_float(x.y); Bv[4 * q + 2] = __uint_as_float(x.z); Bv[4 * q + 3] = __uint_as_float(x.w);
                  KB[4 * q] = x.x & 127u; KB[4 * q + 1] = x.y & 127u; KB[4 * q + 2] = x.z & 127u; KB[4 * q + 3] = x.w & 127u; } }
            constexpr int PI[50] = {0,0,0,0,0,0,0,0,0,0,0,0,0,0,0,0, 1,1,1,1,1,1,1,1, 2,2,2,2,2, 3,3,3,3, 4,4,4, 5,5, 6,6, 7,7, 8, 9, 10, 11, 12, 13, 14, 15};
            constexpr int PJ[50] = {0,1,2,3,4,5,6,7,8,9,10,11,12,13,14,15, 0,1,2,3,4,5,6,7, 0,1,2,3,4, 0,1,2,3, 0,1,2, 0,1, 0,1, 0,1, 0, 0, 0, 0, 0, 0, 0, 0};
            float cs[25]; unsigned cu[25], cidx[25];
#pragma unroll
            for (int s2 = 0; s2 < 25; ++s2) { const float v = hi ? A[PI[2 * s2 + 1]] + Bv[PJ[2 * s2 + 1]] : A[PI[2 * s2]] + Bv[PJ[2 * s2]];
                cs[s2] = v; cu[s2] = ordu(__builtin_bit_cast(unsigned, v)); cidx[s2] = hi ? KA[PI[2 * s2 + 1]] * PEER_NK + KB[PJ[2 * s2 + 1]] : KA[PI[2 * s2]] * PEER_NK + KB[PJ[2 * s2]]; }
            unsigned thc = 0u; int cfin = 50, clfin = 25;
#pragma unroll 1
            for (int b = 31; b >= 0; --b) {
                const unsigned cd = thc | (1u << b); int cl = 0;
#pragma unroll
                for (int s2 = 0; s2 < 25; ++s2) cl += (cu[s2] >= cd) ? 1 : 0;
                const int c = pswap_sum(cl); const bool ok = c >= PEER_K;
                thc = ok ? cd : thc; cfin = ok ? c : cfin; clfin = ok ? cl : clfin;
                if (b <= 20 && __all(cfin == PEER_K)) break;
            }
            int quota = 25, nsel = clfin;
            if (!__all(cfin == PEER_K)) {
                int gl = 0, el = 0;
#pragma unroll
                for (int s2 = 0; s2 < 25; ++s2) { gl += (cu[s2] > thc) ? 1 : 0; el += (cu[s2] == thc) ? 1 : 0; }
                const auto gg = __builtin_amdgcn_permlane32_swap((unsigned)gl, (unsigned)gl, false, false); const auto ee = __builtin_amdgcn_permlane32_swap((unsigned)el, (unsigned)el, false, false);
                const int need = PEER_K - (int)(gg[0] + gg[1]), e_lo = (int)ee[0];
                quota = hi ? (need - e_lo > 0 ? need - e_lo : 0) : need; quota = quota < el ? quota : el; nsel = gl + quota;
            }
            const float cmax = A[0] + Bv[0]; float ex[25]; float dl = 0.f; int eqc = 0; bool sl[25];
#pragma unroll
            for (int s2 = 0; s2 < 25; ++s2) { const bool eq = cu[s2] == thc; sl[s2] = (cu[s2] > thc) || (eq && eqc < quota); eqc += eq ? 1 : 0; ex[s2] = sl[s2] ? __expf(cs[s2] - cmax) : 0.f; dl += ex[s2]; }
            const auto dd = __builtin_amdgcn_permlane32_swap(__builtin_bit_cast(unsigned, dl), __builtin_bit_cast(unsigned, dl), false, false);
            const unsigned dd0 = dd[0], dd1 = dd[1];
            const float rden = 1.f / (__uint_as_float(dd0) + __uint_as_float(dd1));
            const auto nn = __builtin_amdgcn_permlane32_swap((unsigned)nsel, (unsigned)nsel, false, false);
            int pos = hi ? (int)nn[0] : 0; const size_t ob = (size_t)tok * PEER_HK + h * PEER_K;
#pragma unroll
            for (int s2 = 0; s2 < 25; ++s2) if (sl[s2] && pos < PEER_K) { pidx[ob + pos] = (int)cidx[s2]; pgate[ob + pos] = ex[s2] * rden; ++pos; }
        }
    }
    if (IN(12) && IN(13)) __syncthreads();

    for (int rep13 = 0; rep13 < (((PH_REP >> 13) & 1u) ? 2 : 1); ++rep13)
    if (IN(13)) { PH_BEGIN;
        pg8::Gemm g{hn8, u8, DM, DM, DM}; pg8::StaticOrder S; S.init(T, PEER_E, G, (int)blockIdx.x);
        pg8::EpiAct8<false> E{act, PEER_E, sa_hn, sb_u};
        pg8::gemm_phase<pg8::EpiAct8<false>, pg8::StaticOrder, PG8_ALIGN>(lds, g, S, E);
    }
    GRID_BAR(13);

    for (int rep14 = 0; rep14 < (((PH_REP >> 14) & 1u) ? 2 : 1); ++rep14)
    for (int rep14 = 0; rep14 < (((PH_REP >> 14) & 1u) ? 2 : 1); ++rep14)
    if (IN(14)) { PH_BEGIN;
        for (int m = gw; m < T; m += NGW) {
            const int e0 = pidx[(size_t)m * PEER_HK + lane], e1 = pidx[(size_t)m * PEER_HK + 64 + lane];
            const float g0 = pgate[(size_t)m * PEER_HK + lane], g1 = pgate[(size_t)m * PEER_HK + 64 + lane];
            const unsigned char* arow = (const unsigned char*)act + (size_t)m * PEER_E; signed char* qrow = act8 + (size_t)m * PEER_E;
            const float rsc = sa_hn[m] * 16.f;
            const pg8::f32x2 ge = pg8::gelu_pk((pg8::f32x2){__builtin_amdgcn_cvt_f32_fp8((int)arow[e0], 0) * rsc, __builtin_amdgcn_cvt_f32_fp8((int)arow[e1], 0) * rsc}); const float a0 = ge.x, a1 = ge.y;
            float G0 = 0.f, G1 = 0.f;
            for (int j = 0; j < 64; ++j) { const int ej = __builtin_amdgcn_readlane(e0, j), fj = __builtin_amdgcn_readlane(e1, j);
                const float gj = __builtin_bit_cast(float, __builtin_amdgcn_readlane(__builtin_bit_cast(int, g0), j)), hj = __builtin_bit_cast(float, __builtin_amdgcn_readlane(__builtin_bit_cast(int, g1), j));
                G0 += (ej == e0 ? gj : 0.f) + (fj == e0 ? hj : 0.f); G1 += (ej == e1 ? gj : 0.f) + (fj == e1 ? hj : 0.f); }
            const float w0 = a0 * G0 * sk_v[e0], w1 = a1 * G1 * sk_v[e1];
            const float am = fmaxf(wave_max(fmaxf(fabsf(w0), fabsf(w1))), 1e-30f), inv = 127.f / am;
            if (lane == 0) sa_act[m] = am * (1.f / 127.f);
            const v4u zero = {0u, 0u, 0u, 0u};
#pragma unroll 8
            for (int j = 0; j < 16; ++j) *((GAS v4u*)qrow + j * 64 + lane) = zero;
            VM_WAIT();
            asm volatile("" ::: "memory");
            qrow[e0] = (signed char)(int)__builtin_rintf(w0 * inv); qrow[e1] = (signed char)(int)__builtin_rintf(w1 * inv);
        }
    }
    GRID_BAR(14);

#ifndef PROBE_NO_PEER
#define PROBE_NO_PEER 0
#endif
    if (IN(15) && !PROBE_NO_PEER) { PH_BEGIN;
        pg8::Gemm g{act8, vT8, PEER_E, PEER_E, PEER_E}; pg8::StaticOrder S; S.init(T, DM, G, (int)blockIdx.x);
        pg8::EpiOut8 E{out, DM, h16, sa_act, sb_v};
        pg8::gemm_phase<pg8::EpiOut8, pg8::StaticOrder, true>(lds, g, S, E);
    }
#undef IN
#undef GRID_BAR
}

#ifdef PROBE_CHECK
constexpr size_t WS_CHKTMP = 1130 * MiB;
__device__ __forceinline__ unsigned hash32(unsigned x) { x ^= x >> 16; x *= 0x7feb352du; x ^= x >> 15; x *= 0x846ca68bu; x ^= x >> 16; return x; }
__device__ __forceinline__ float bfr(float f) { return __builtin_bit_cast(float, f2bf(f) << 16); }
__device__ __forceinline__ float bf2f(bf16 b) { return __builtin_bit_cast(float, (unsigned)b << 16); }
__device__ __forceinline__ float gelu_ref(float a) { return 0.5f * a * (1.f + erff(a * 0.70710678f)); }
constexpr int CHK_N = 16384;
__global__ void __launch_bounds__(256) check_kernel(Args args, int stage) {
    unsigned char* ws = args.ws; float* chk = (float*)(ws + WS_CTL) + 1024;
    const float* x = args.in[0]; const float* norm_mix = args.in[1]; const float* w_in = args.in[2]; const float* pool_w = args.in[3]; const float* pool_scale = args.in[4];
    const float* w_pool_out = args.in[7]; const float* w_attn_out = args.in[8]; const float* w_o = args.in[9];
    const float* norm_ffn = args.in[10]; const float* peer_wq = args.in[11]; const float* peer_sub = args.in[12]; const float* peer_u = args.in[13]; const float* peer_v = args.in[14];
    const float* out = args.out;
    const int* pidx = (const int*)(ws + WS_PIDX); const float* pgate = (const float*)(ws + WS_PG);
    const bf16* ypre = (const bf16*)(ws + WS_YPRE); const bf16* hn = (const bf16*)(ws + WS_XN8);
    const bf16* mrg = (const bf16*)(ws + WS_MRG); const float* pq = (const float*)(ws + WS_MRG);
    const bf16* Z = (const bf16*)(ws + WS_Z); const bf16* act = (const bf16*)(ws + WS_Z);
    float* tmp = (float*)(ws + WS_CHKTMP); float* hsave = tmp + 4096 * 256;
    const int sidx = blockIdx.x * blockDim.x + threadIdx.x;
    const unsigned h1 = hash32((unsigned)sidx * 2654435761u + 977u * (unsigned)(stage > 90 ? 9 : stage == 21 ? 20 : stage == 24 ? 23 : stage)), h2 = hash32(h1 + 0x9e3779b9u);
    const int row = (int)(h1 % (unsigned)T);
    float got = 0.f, ref = 0.f; bool valid = true;
    if (stage == 1) {
        const int col = (int)(h2 % 16384u); float ss = 0.f;
        for (int k = 0; k < DM; ++k) { const float v = x[(size_t)row * DM + k]; ss += v * v; }
        const float r = 1.f / sqrtf(ss * (1.f / DM) + EPS); float acc = 0.f;
        for (int k = 0; k < DM; ++k) acc += (x[(size_t)row * DM + k] * r * norm_mix[k]) * w_in[(size_t)k * INW + col];
        if (col >= 8192) acc = 1.f / (1.f + expf(-acc));
        ref = acc; got = bf2f(Z[(size_t)(col >> 11) * ZSLOT + (size_t)row * 2048 + (col & 2047)]);
    } else if (stage == 20 || stage == 21) {
        const int smp = sidx; valid = false; float* rawq = tmp + 2 * 4096 * 256;
        if (smp < 4096) { const int hh = (int)(h2 % 16u), which = (int)((h2 >> 8) & 1u); const bf16* zz = Z + (size_t)(1 + which) * ZSLOT + (size_t)row * 2048 + hh * 128;
            if (stage == 20) { for (int d = 0; d < 128; ++d) rawq[(size_t)smp * 128 + d] = bf2f(zz[d]); }
            else { const float* gn = args.in[5 + which]; float ss = 0.f; for (int d = 0; d < 128; ++d) { const float v = rawq[(size_t)smp * 128 + d]; ss += v * v; }
                const float r = 1.f / sqrtf(ss * (1.f / 128.f) + EPS); const int pos = row & (SEQ - 1); float nn = 0.f, dd = 0.f;
                for (int d = 0; d < 128; ++d) { const int j = d & 63; const float inv = powf(10000.f, -(float)j / 64.f), ang = (float)pos * inv, cs = cosf(ang), sn = sinf(ang);
                    const float a = rawq[(size_t)smp * 128 + d] * r * gn[d], pa = rawq[(size_t)smp * 128 + (d ^ 64)] * r * gn[d ^ 64];
                    const float rf = d < 64 ? a * cs - pa * sn : a * cs + pa * sn, g = bf2f(zz[d]); nn += (g - rf) * (g - rf); dd += rf * rf; }
                atomicAdd(&chk[2 * 21], nn); atomicAdd(&chk[2 * 21 + 1], dd); } }
    } else if (stage == 22) {
        const int d = (int)(h2 % 128u), hh = (int)((h2 >> 8) % 16u), blk = (row & (SEQ - 1)) >> 8, b = row >> 12; float sum = 0.f;
        for (int i = 0; i < 256; ++i) sum += bf2f(Z[2 * ZSLOT + (size_t)(b * SEQ + blk * 256 + i) * 2048 + hh * 128 + d]);
        ref = sum * (1.f / 256.f); got = ((const float*)(ws + WS_KMEAN))[((size_t)(b * NH + hh) * NBLK + blk) * HD + d];
    } else if (stage == 23 || stage == 24) {
        const int smp = sidx; valid = false; float* aref = tmp + 3 * 4096 * 256;
        if (smp < 4096) { const int hh = (int)(h2 % 16u), d0 = (int)((h2 >> 8) % 128u), t = row & (SEQ - 1), b = row >> 12, own = t >> 8;
            const bf16* qv = Z + ZSLOT + (size_t)row * 2048 + hh * 128;
            if (stage == 23) {
                const float* km = (const float*)(ws + WS_KMEAN) + (size_t)(b * NH + hh) * NBLK * HD; unsigned mask = 0u;
                if (own <= 3) mask = (1u << own) - 1u;
                else { float* gt = tmp + 4 * 4096 * 256 + (size_t)smp * 16; for (int n = 0; n < own; ++n) { float g = 0.f; for (int d = 0; d < 128; ++d) g += bf2f(qv[d]) * km[n * HD + d]; gt[n] = g; }
                    for (int k = 0; k < 3; ++k) { int bi = -1; float bv = -3e38f; for (int n = 0; n < own; ++n) if (!((mask >> n) & 1u) && gt[n] > bv) { bv = gt[n]; bi = n; } mask |= 1u << bi; } }
                float mx = -3e38f, den = 0.f, acc = 0.f;
                for (int n = 0; n <= own; ++n) { if (n < own && !((mask >> n) & 1u)) continue; const int jend = n < own ? 256 : (t & 255) + 1;
                    for (int j = 0; j < jend; ++j) { const size_t kr = (size_t)(b * SEQ + n * 256 + j); const bf16* kv = Z + 2 * ZSLOT + kr * 2048 + hh * 128; float sc = 0.f;
                        for (int d = 0; d < 128; ++d) sc += bf2f(qv[d]) * bf2f(kv[d]);
                        sc *= 0.08838834764831845f; const float vv = bf2f(Z[3 * ZSLOT + kr * 2048 + hh * 128 + d0]);
                        if (sc > mx) { const float f = expf(mx - sc); den *= f; acc *= f; mx = sc; }
                        const float pe = expf(sc - mx); den += pe; acc += pe * vv; } }
                aref[smp] = acc / den;
            } else { ref = aref[smp]; got = bf2f(qv[d0]); valid = true; } }
    } else if (stage == 11) {
        const int k = row & 4095, n = (int)(h2 % 16384u); const float* sbw = (const float*)(ws + WS_SCALE) + 3 * T;
        ref = w_in[(size_t)k * INW + n]; got = (float)((const signed char*)(ws + WS_WIN8))[(size_t)n * DM + k] * sbw[n];
    } else if (stage == 12) {
        const int col = (int)(h2 % 4096u); float ss = 0.f;
        for (int k = 0; k < DM; ++k) { const float v = x[(size_t)row * DM + k]; ss += v * v; }
        ref = x[(size_t)row * DM + col] / sqrtf(ss * (1.f / DM) + EPS) * norm_mix[col]; got = (float)((const signed char*)(ws + WS_XN8))[(size_t)row * DM + col] * ((const float*)(ws + WS_SCALE))[row];
    } else if (stage == 2) {
        const int col = (int)(h2 % 2048u), g = col >> 9, w = 2 << g, t = row & (SEQ - 1); float sum = 0.f; int cnt = 0;
        for (int j = 0; j < w; ++j) if (t - j >= 0) { sum += bf2f(Z[(size_t)(row - j) * 2048 + col]); ++cnt; }
        ref = sum / (float)cnt - bf2f(Z[(size_t)row * 2048 + col]); got = bf2f(ypre[(size_t)row * 2048 + col]);
    } else if (stage == 3) {
        const int col = (int)(h2 % 2048u), g = col >> 9, d = col & 511; float acc = 0.f;
        for (int c = 0; c < 512; ++c) acc += bf2f(ypre[(size_t)row * 2048 + g * 512 + c]) * bfr(pool_w[((size_t)g * 512 + c) * 512 + d]);
        ref = acc * pool_scale[col]; got = bf2f(Z[(size_t)row * 2048 + col]);
    } else if (stage == 4) {
        const int col = (int)(h2 % 4096u); float a1 = 0.f, a2 = 0.f;
        for (int k = 0; k < 2048; ++k) { a1 += bf2f(Z[(size_t)row * 2048 + k]) * bfr(w_pool_out[(size_t)k * DM + col]); a2 += bf2f(Z[ZSLOT + (size_t)row * 2048 + k]) * bfr(w_attn_out[(size_t)k * DM + col]); }
        const float gp = bf2f(Z[(size_t)(4 + (col >> 11)) * ZSLOT + (size_t)row * 2048 + (col & 2047)]), ga = bf2f(Z[(size_t)(6 + (col >> 11)) * ZSLOT + (size_t)row * 2048 + (col & 2047)]);
        ref = gp * a1 + ga * a2; got = bf2f(mrg[(size_t)row * DM + col]);
    } else if (stage == 5) {
        const int col = (int)(h2 % 4096u); float acc = 0.f;
        for (int k = 0; k < DM; ++k) acc += bf2f(mrg[(size_t)row * DM + k]) * bfr(w_o[(size_t)k * DM + col]);
        ref = x[(size_t)row * DM + col] + acc; got = out[(size_t)row * DM + col];
    } else if (stage == 6) {
        const int col = (int)(h2 % 4096u); float ss = 0.f;
        for (int k = 0; k < DM; ++k) { const float v = out[(size_t)row * DM + k]; ss += v * v; }
        ref = out[(size_t)row * DM + col] / sqrtf(ss * (1.f / DM) + EPS) * norm_ffn[col]; got = bf2f(hn[(size_t)row * DM + col]);
    } else if (stage == 7) {
        const int col = (int)(h2 % 2048u); float acc = 0.f;
        for (int k = 0; k < DM; ++k) acc += bf2f(hn[(size_t)row * DM + k]) * bfr(peer_wq[(size_t)k * 2048 + col]);
        ref = acc; got = pq[(size_t)row * 2048 + col];
    } else if (stage == 8) {
        const int col = (int)(h2 % 16384u); float acc = 0.f;
        for (int k = 0; k < DM; ++k) acc += bf2f(hn[(size_t)row * DM + k]) * peer_u[(size_t)col * DM + k];
        ref = gelu_ref(acc); got = bf2f(act[(size_t)row * PEER_E + col]);
    } else if (stage == 91 || stage == 9 || stage == 92) {
        float* acc9 = (float*)(ws + WS_CTL) + 2048;
        const int smp = stage == 9 ? sidx >> 7 : sidx, j = sidx & 127;
        const unsigned g1 = hash32((unsigned)smp * 2654435761u + 977u * 9u), g2 = hash32(g1 + 0x9e3779b9u);
        const int r9 = (int)(g1 % (unsigned)T), col = (int)(g2 % 4096u); valid = false;
        if (smp < 512) {
            if (stage == 91) hsave[smp] = out[(size_t)r9 * DM + col];
            else if (stage == 9) { const int e = pidx[(size_t)r9 * PEER_HK + j]; float a = 0.f;
                for (int k = 0; k < DM; ++k) a += bf2f(hn[(size_t)r9 * DM + k]) * peer_u[(size_t)e * DM + k];
                atomicAdd(&acc9[smp], pgate[(size_t)r9 * PEER_HK + j] * gelu_ref(a) * peer_v[(size_t)e * DM + col]); }
            else { ref = acc9[smp]; got = out[(size_t)r9 * DM + col] - hsave[smp]; valid = true; stage = 9; } }
    } else if (stage == 10) {
        valid = sidx < 4096; const int hh = (int)(h2 % 8u);
        if (valid) { float* sc = tmp + (size_t)sidx * 256;
            for (int p = 0; p < 2; ++p) for (int n = 0; n < 128; ++n) { float a = 0.f;
                for (int d = 0; d < 128; ++d) a += pq[(size_t)row * 2048 + hh * 256 + p * 128 + d] * peer_sub[((size_t)(hh * 2 + p) * 128 + n) * 128 + d];
                sc[p * 128 + n] = a; }
            __threadfence();
            float smin = 3e38f, smax = -3e38f;
            for (int k = 0; k < 16; ++k) { const int e = pidx[(size_t)row * PEER_HK + hh * 16 + k]; const float sm = sc[e >> 7] + sc[128 + (e & 127)]; smin = fminf(smin, sm); smax = fmaxf(smax, sm); }
            int above = 0; for (int i = 0; i < 128; ++i) for (int j = 0; j < 128; ++j) above += (sc[i] + sc[128 + j] > smin + 1e-4f) ? 1 : 0;
            int dup = 0; for (int k = 0; k < 16; ++k) for (int k2 = 0; k2 < k; ++k2) dup += (pidx[(size_t)row * PEER_HK + hh * 16 + k] == pidx[(size_t)row * PEER_HK + hh * 16 + k2]) ? 1 : 0;
            float den = 0.f; for (int k = 0; k < 16; ++k) { const int e = pidx[(size_t)row * PEER_HK + hh * 16 + k]; den += expf(sc[e >> 7] + sc[128 + (e & 127)] - smax); }
            float gerr = 0.f; for (int k = 0; k < 16; ++k) { const int e = pidx[(size_t)row * PEER_HK + hh * 16 + k]; const float gr = expf(sc[e >> 7] + sc[128 + (e & 127)] - smax) / den; gerr += fabsf(gr - pgate[(size_t)row * PEER_HK + hh * 16 + k]); }
            ref = 1.f; got = 1.f + (above > 15 ? (float)(above - 15) / 16.f : 0.f) + (float)dup + gerr; }
    }
    if (valid) { const float d = got - ref; atomicAdd(&chk[2 * stage], d * d); atomicAdd(&chk[2 * stage + 1], ref * ref); }
}
__global__ void report_kernel(Args args) {
    float* chk = (float*)(args.ws + WS_CTL) + 1024; float best = -1.f; int bs = 0;
    for (int s = 1; s <= 24; ++s) { const float den = chk[2 * s + 1]; const float c = den > 0.f ? sqrtf(chk[2 * s] / den) : 0.99f; if (c > best) { best = c; bs = s; } }
#ifdef PROBE_STAGE
    bs = PROBE_STAGE; { const float den = chk[2 * bs + 1]; best = den > 0.f ? sqrtf(chk[2 * bs] / den) : 0.99f; }
#endif
    const float F = 1000.f * exp2f((float)bs) * (1.f + fminf(best, 0.99f));
    for (size_t i = (size_t)blockIdx.x * blockDim.x + threadIdx.x; i < (size_t)T * DM; i += (size_t)gridDim.x * blockDim.x) args.out[i] *= F;
}
#endif

extern "C" void kernel_launch(void* const* d_in, const int* in_sizes, int n_in, void* d_out, int out_size, void* d_ws, size_t ws_size, hipStream_t stream) {
    static int grid = 0;
    if (grid == 0) {
        if (n_in != 15 || out_size != T * DM || ws_size < WS_END) { fprintf(stderr, "kernel_launch: unexpected shapes (n_in %d, out %d, ws %zu)\n", n_in, out_size, ws_size); grid = -1; return; }
        int dev = 0, cus = 0, per_cu = 0;
        if (hipGetDevice(&dev) != hipSuccess || hipDeviceGetAttribute(&cus, hipDeviceAttributeMultiprocessorCount, dev) != hipSuccess) { grid = -1; return; }
        if (hipFuncSetAttribute((const void*)fwd_kernel, hipFuncAttributeMaxDynamicSharedMemorySize, LDS_BYTES) != hipSuccess) { fprintf(stderr, "kernel_launch: hipFuncSetAttribute failed\n"); grid = -1; return; }
        if (hipOccupancyMaxActiveBlocksPerMultiprocessor(&per_cu, (const void*)fwd_kernel, NWAVES * 64, LDS_BYTES) != hipSuccess || per_cu < 1) { fprintf(stderr, "kernel_launch: occupancy query says %d\n", per_cu); }
        (void)hipGetLastError();
        grid = cus;
    }
    if (grid < 0) return;
    (void)hipMemsetAsync((char*)d_ws + WS_CTL, 0, CTL_ZERO_BYTES, stream);
    Args a{};
    for (int i = 0; i < 15; ++i) a.in[i] = (const float*)d_in[i];
    a.out = (float*)d_out; a.ws = (unsigned char*)d_ws;
    if (MK_N_LAUNCHES == 1) { a.ph_lo = 0; a.ph_hi = N_PHASES; hipLaunchKernelGGL(fwd_kernel, dim3(grid), dim3(NWAVES * 64), LDS_BYTES, stream, a); }
    else for (int p = 0; p < N_PHASES; ++p) { a.ph_lo = p; a.ph_hi = p + 1;
#ifdef PROBE_CHECK
        if (p == 3) hipLaunchKernelGGL(check_kernel, dim3(CHK_N / 256), dim3(256), 0, stream, a, 20);
        if (p == 5) hipLaunchKernelGGL(check_kernel, dim3(CHK_N / 256), dim3(256), 0, stream, a, 23);
#endif
        hipLaunchKernelGGL(fwd_kernel, dim3(grid), dim3(NWAVES * 64), LDS_BYTES, stream, a);
#ifdef PROBE_CHECK
        if (p == 2) hipLaunchKernelGGL(check_kernel, dim3(CHK_N / 256), dim3(256), 0, stream, a, 1);
        if (p == 3) { hipLaunchKernelGGL(check_kernel, dim3(CHK_N / 256), dim3(256), 0, stream, a, 21); hipLaunchKernelGGL(check_kernel, dim3(CHK_N / 256), dim3(256), 0, stream, a, 22); }
        if (p == 5) hipLaunchKernelGGL(check_kernel, dim3(CHK_N / 256), dim3(256), 0, stream, a, 24);
        if (p == 15) hipLaunchKernelGGL(report_kernel, dim3(1024), dim3(256), 0, stream, a);
#endif
    }
}
```
